# Optimizing an MI355X kernel written in HIP

```python
import math
import jax, jax.numpy as jnp
from jax import lax
import numpy as np

D_MODEL = 2048
BATCH = 16
SEQ = 256
DEPTH = 2
DEC_BATCH = 8
DEC_SEQ = 1024
PAST_LEN = 256

GRID_W = 64
D_MIX = D_MODEL
D_SSM = D_MIX // 2
D_CONV = D_MIX - D_SSM
SSM_H = 16
SSM_GROUPS = D_SSM // SSM_H
SSM_STATE = 64
N_DIR = 2
CONV_W = 3
CONV_HEADS = 16
D_IN = D_SSM + 3 * D_CONV
D_FF = ((8 * D_MODEL + 3 * 256 - 1) // (3 * 256)) * 256
N_MOD = 6
EPS = 1e-6
LAM_RE_MAX = -1e-4
DT_MIN = 1e-3
DT_MAX = 1e-1

kernel_name = 'hymba_s5_shortconv_prefix_dit_step'


def rms_norm(x, g):
    xf = x.astype(jnp.float32)
    y = xf * lax.rsqrt(jnp.mean(xf * xf, axis=-1, keepdims=True) + EPS)
    return (y * g.astype(jnp.float32)).astype(x.dtype)


def modulation(cond, w, b):
    m = (jax.nn.silu(cond) @ w + b).reshape(cond.shape[0], N_MOD, 1, D_MODEL)
    return [m[:, i] for i in range(N_MOD)]


def _scan_combine(left, right):
    a_l, b_l = left
    a_r, b_r = right
    return a_r * a_l, a_r * b_l + b_r


def s5_direction(u, lam_re, lam_im, log_dt, b_re, b_im, c_re, c_im, s0, reverse):
    f32 = jnp.float32
    lam = lax.complex(jnp.minimum(lam_re.astype(f32), LAM_RE_MAX), lam_im.astype(f32))
    dt = jnp.exp(log_dt.astype(f32))[:, None]
    a_bar = jnp.exp(lam * dt)
    b_bar = ((a_bar - 1.0) / lam)[..., None] * lax.complex(b_re.astype(f32), b_im.astype(f32))
    bu = lax.complex(jnp.einsum('blgh,gph->blgp', u, b_bar.real),
                     jnp.einsum('blgh,gph->blgp', u, b_bar.imag))
    if s0 is not None:
        first = -1 if reverse else 0
        bu = bu.at[:, first].add(a_bar * s0)
    a = jnp.broadcast_to(a_bar, bu.shape)
    _, xs = lax.associative_scan(_scan_combine, (a, bu), axis=1, reverse=reverse)
    y = (jnp.einsum('blgp,ghp->blgh', xs.real, c_re.astype(f32))
         - jnp.einsum('blgp,ghp->blgh', xs.imag, c_im.astype(f32)))
    final = xs[:, 0] if reverse else xs[:, -1]
    return y, final


def conv3(z, w, b):
    zp = jnp.pad(z, [(0, 0)] * (z.ndim - 2) + [(1, 1), (0, 0)])
    return zp[..., :-2, :] * w[0] + zp[..., 1:-1, :] * w[1] + zp[..., 2:, :] * w[2] + b


def token_mixers(h, w_in, lam_re, lam_im, log_dt, b_re, b_im, c_re, c_im, d_skip, w_glu,
                 conv_w, conv_b, w_out, s0, on_grid):
    bsz, length, _ = h.shape
    z = h @ w_in
    u, gb, gc, v = jnp.split(z, [D_SSM, D_SSM + D_CONV, D_SSM + 2 * D_CONV], axis=-1)
    uf = u.astype(jnp.float32)
    ug = uf.reshape(bsz, length, SSM_GROUPS, SSM_H)
    ys, finals = [], []
    for d in range(N_DIR):
        y_d, f_d = s5_direction(ug, lam_re[d], lam_im[d], log_dt[d], b_re[d], b_im[d],
                                c_re[d], c_im[d], None if s0 is None else s0[d], d == 1)
        ys.append(y_d)
        finals.append(f_d)
    y = (ys[0] + ys[1]).reshape(bsz, length, D_SSM) + d_skip.astype(jnp.float32) * uf
    y = jax.nn.gelu(y).astype(h.dtype)
    y_ssm = y * jax.nn.sigmoid(y @ w_glu)
    zc = gc * v
    if on_grid:
        rows = length // GRID_W
        zc = conv3(zc.reshape(bsz, rows, GRID_W, D_CONV), conv_w, conv_b).reshape(bsz, length, D_CONV)
    else:
        zc = conv3(zc, conv_w, conv_b)
    y_conv = gb * zc
    out = jnp.concatenate([y_ssm, y_conv], axis=-1) @ w_out
    return out, finals


def setup_inputs(seed: int = 0) -> dict:
    key = jax.random.key(seed)
    ks = jax.random.split(key, 32)
    f32 = jnp.float32

    def nrm(k, shape, scale):
        return jax.random.normal(k, shape, f32) * scale

    gs = (DEPTH, N_DIR, SSM_GROUPS)
    lam_im_base = jnp.pi * jnp.arange(SSM_STATE, dtype=f32)
    return {
        'x_prompt': nrm(ks[0], (BATCH, SEQ, D_MODEL), 1.0),
        'x_sample': nrm(ks[1], (DEC_BATCH, DEC_SEQ, D_MODEL), 1.0),
        'state_ssm': nrm(ks[2], (DEC_BATCH, DEPTH, N_DIR, 2, SSM_GROUPS, SSM_STATE), 0.5),
        'c': nrm(ks[3], (DEC_BATCH, D_MODEL), 1.0),
        'c_ctx': nrm(ks[4], (D_MODEL,), 1.0),
        'w_ada': nrm(ks[5], (DEPTH, D_MODEL, N_MOD * D_MODEL), 0.5 * D_MODEL ** -0.5),
        'b_ada': nrm(ks[6], (DEPTH, N_MOD * D_MODEL), 0.02),
        'g_mix': 1.0 + nrm(ks[7], (DEPTH, D_MODEL), 0.02),
        'w_in': nrm(ks[8], (DEPTH, D_MODEL, D_IN), D_MODEL ** -0.5),
        'ssm_lam_re': -0.5 + nrm(ks[9], gs + (SSM_STATE,), 0.01),
        'ssm_lam_im': lam_im_base + nrm(ks[10], gs + (SSM_STATE,), 0.01),
        'ssm_log_dt': jax.random.uniform(ks[11], gs, f32, math.log(DT_MIN), math.log(DT_MAX)),
        'ssm_b_re': nrm(ks[12], gs + (SSM_STATE, SSM_H), (2.0 * SSM_H) ** -0.5),
        'ssm_b_im': nrm(ks[13], gs + (SSM_STATE, SSM_H), (2.0 * SSM_H) ** -0.5),
        'ssm_c_re': nrm(ks[14], gs + (SSM_H, SSM_STATE), (2.0 * SSM_STATE) ** -0.5),
        'ssm_c_im': nrm(ks[15], gs + (SSM_H, SSM_STATE), (2.0 * SSM_STATE) ** -0.5),
        'ssm_d': nrm(ks[16], (DEPTH, D_SSM), 0.5),
        'w_glu': nrm(ks[17], (DEPTH, D_SSM, D_SSM), D_SSM ** -0.5),
        'conv_w': nrm(ks[18], (DEPTH, CONV_W, D_CONV), CONV_W ** -0.5),
        'conv_b': nrm(ks[19], (DEPTH, D_CONV), 0.02),
        'w_out': nrm(ks[20], (DEPTH, D_MIX, D_MODEL), D_MIX ** -0.5),
        'g_ffn': 1.0 + nrm(ks[21], (DEPTH, D_MODEL), 0.02),
        'w_gate': nrm(ks[22], (DEPTH, D_MODEL, D_FF), D_MODEL ** -0.5),
        'w_up': nrm(ks[23], (DEPTH, D_MODEL, D_FF), D_MODEL ** -0.5),
        'w_down': nrm(ks[24], (DEPTH, D_FF, D_MODEL), D_FF ** -0.5),
        'g_final': 1.0 + nrm(ks[25], (D_MODEL,), 0.02),
    }


def reference(x_prompt, x_sample, state_ssm, c, c_ctx, w_ada, b_ada, g_mix, w_in,
              ssm_lam_re, ssm_lam_im, ssm_log_dt, ssm_b_re, ssm_b_im, ssm_c_re, ssm_c_im,
              ssm_d, w_glu, conv_w, conv_b, w_out, g_ffn, w_gate, w_up, w_down, g_final):

    def layer(x, cond, l, s0, on_grid):
        sh1, sc1, g1, sh2, sc2, g2 = modulation(cond, w_ada[l], b_ada[l])
        h = rms_norm(x, g_mix[l]) * (1.0 + sc1) + sh1
        out, finals = token_mixers(h, w_in[l], ssm_lam_re[l], ssm_lam_im[l], ssm_log_dt[l],
                                   ssm_b_re[l], ssm_b_im[l], ssm_c_re[l], ssm_c_im[l], ssm_d[l],
                                   w_glu[l], conv_w[l], conv_b[l], w_out[l], s0, on_grid)
        x = x + g1 * out
        h = rms_norm(x, g_ffn[l]) * (1.0 + sc2) + sh2
        x = x + g2 * ((jax.nn.silu(h @ w_gate[l]) * (h @ w_up[l])) @ w_down[l])
        return x, finals

    ctx_cond = c_ctx[None, :]
    xp = x_prompt
    per_layer_states = []
    for l in range(DEPTH):
        xp, finals = layer(xp, ctx_cond, l, None, False)
        per_layer_states.append(jnp.stack([jnp.stack([f.real, f.imag], axis=1) for f in finals], axis=1))
    y_prompt = rms_norm(xp, g_final)
    new_state_ssm = jnp.stack(per_layer_states, axis=1).astype(x_prompt.dtype)

    xs = x_sample
    for l in range(DEPTH):
        st = state_ssm[:, l].astype(jnp.float32)
        s0 = [lax.complex(st[:, d, 0], st[:, d, 1]) for d in range(N_DIR)]
        xs, _ = layer(xs, c, l, s0, True)
    y_sample = rms_norm(xs, g_final)

    return (y_prompt, y_sample, new_state_ssm)
```

```cpp
#include <hip/hip_runtime.h>
#include <hip/hip_cooperative_groups.h>
#include <cstdio>
#include <cstdint>
namespace pg8 {
#define PG8_LAS __attribute__((address_space(3)))
typedef unsigned short bf16_t;
typedef short bf16x8 __attribute__((ext_vector_type(8)));
typedef float f32x4 __attribute__((ext_vector_type(4)));
typedef unsigned u32x4 __attribute__((ext_vector_type(4)));
constexpr int BM = 256, BK = 64, HALF = 128, HTB = HALF * BK * 2  , STAGE_BYTES = 8 * HTB, NXCD = 8, WGM = 6;

__host__ __device__ __forceinline__ int lds_byte(int r, int c) { const int st = (r >> 4) * 2 + (c >> 5), rr = r & 15, cc = c & 31, ob = rr * 64 + cc * 2; return st * 1024 + (ob ^ (((ob >> 9) & 1) << 5)); }
__host__ __device__ __forceinline__ void stage_rc(int b, int& R, int& C) { const int st = b / 1024, sb = b % 1024, swz = sb ^ (((sb >> 9) & 1) << 5); R = (st >> 1) * 16 + swz / 64; C = (st & 1) * 32 + (swz % 64) / 2; }
__host__ __device__ __forceinline__ int perm32(int rho) { const int n = rho >> 4, i = rho & 15; return 8 * (i >> 2) + 4 * n + (i & 3); }

struct Unit { int pm, pn, kh, flags; };
struct Gemm { const bf16_t* A; const bf16_t* Bt; int M, N, K, ld; };

struct StaticOrder {
    int nM, nN, nwg, G, c;
    __host__ __device__ void init(int M, int N, int G_, int c_) { nM = M / BM; nN = N / BM; nwg = nM * nN; G = G_; c = c_; }
    __host__ __device__ bool next(int i, Unit& u) const {
        const long L = (long)i * G + c; if (L >= nwg) return false;
        int wgid = (int)L; { const int q = nwg / NXCD, r = nwg % NXCD, xcd = wgid % NXCD, off = wgid / NXCD; wgid = (xcd < r ? xcd * (q + 1) : r * (q + 1) + (xcd - r) * q) + off; }
        const int nig = WGM * nN, gid = wgid / nig, fm = gid * WGM, gsz = (nM - fm) < WGM ? (nM - fm) : WGM;
        u.pm = fm + ((wgid % nig) % gsz); u.pn = (wgid % nig) / gsz; u.kh = 0; u.flags = 0; return true;
    }
    __device__ __forceinline__ void a_ready(const Unit&) const {}
    __device__ __forceinline__ void done(const Unit&) const {}
};
typedef float f32x2cv __attribute__((ext_vector_type(2))); typedef __bf16 bf16x2cv __attribute__((ext_vector_type(2)));
__device__ __forceinline__ unsigned cvt_pk_bf16(float lo, float hi) { const f32x2cv v = {lo, hi}; const bf16x2cv b = __builtin_convertvector(v, bf16x2cv); return __builtin_bit_cast(unsigned, b); }
typedef float f32x2 __attribute__((ext_vector_type(2)));
typedef float f32x2 __attribute__((ext_vector_type(2)));
__device__ __forceinline__ float bf_lo(unsigned w) { return __uint_as_float(w << 16); }
__device__ __forceinline__ float bf_hi(unsigned w) { return __uint_as_float(w & 0xffff0000u); }
__device__ __forceinline__ float sigmoid_f(float g) { return __builtin_amdgcn_rcpf(1.0f + __expf(-g)); }

struct EpiStoreBf16 {
    static constexpr bool PERM = true, AFTER_DRAIN = false;
    bf16_t* O; int ldc;
    __device__ __forceinline__ void operator()(const f32x4 (&acc)[2][2][4][2], const Unit& u, int wr, int wc, int fr, int fq) const {
        const int row0 = u.pm * BM + wr * 64 + fr, col0 = u.pn * BM + wc * 32 + 8 * fq;
#pragma unroll
        for (int ai = 0; ai < 2; ++ai)
#pragma unroll
            for (int m = 0; m < 4; ++m) { bf16_t* rowp = O + (size_t)(row0 + ai * HALF + m * 16) * ldc + col0;
#pragma unroll
                for (int bj = 0; bj < 2; ++bj) { const f32x4 v0 = acc[ai][bj][m][0], v1 = acc[ai][bj][m][1];
                    u32x4 w; w.x = cvt_pk_bf16(v0[0], v0[1]); w.y = cvt_pk_bf16(v0[2], v0[3]); w.z = cvt_pk_bf16(v1[0], v1[1]); w.w = cvt_pk_bf16(v1[2], v1[3]);
                    *(u32x4*)(rowp + bj * HALF) = w; } }
    }
};
struct EpiGLU {
    static constexpr bool PERM = true, AFTER_DRAIN = false;
    const bf16_t* Y; int ldy; bf16_t* O; int ldc;
    __device__ __forceinline__ void operator()(const f32x4 (&acc)[2][2][4][2], const Unit& u, int wr, int wc, int fr, int fq) const {
        const int row0 = u.pm * BM + wr * 64 + fr, col0 = u.pn * BM + wc * 32 + 8 * fq;
#pragma unroll
        for (int ai = 0; ai < 2; ++ai)
#pragma unroll
            for (int m = 0; m < 4; ++m) { const size_t r = (size_t)(row0 + ai * HALF + m * 16);
#pragma unroll
                for (int bj = 0; bj < 2; ++bj) { const f32x4 v0 = acc[ai][bj][m][0], v1 = acc[ai][bj][m][1];
                    const u32x4 y = *(const u32x4*)(Y + r * ldy + col0 + bj * HALF);
                    u32x4 w;
                    w.x = cvt_pk_bf16(bf_lo(y.x) * sigmoid_f(v0[0]), bf_hi(y.x) * sigmoid_f(v0[1]));
                    w.y = cvt_pk_bf16(bf_lo(y.y) * sigmoid_f(v0[2]), bf_hi(y.y) * sigmoid_f(v0[3]));
                    w.z = cvt_pk_bf16(bf_lo(y.z) * sigmoid_f(v1[0]), bf_hi(y.z) * sigmoid_f(v1[1]));
                    w.w = cvt_pk_bf16(bf_lo(y.w) * sigmoid_f(v1[2]), bf_hi(y.w) * sigmoid_f(v1[3]));
                    *(u32x4*)(O + r * ldc + col0 + bj * HALF) = w; } }
    }
};
struct EpiResid {
    static constexpr bool PERM = true, AFTER_DRAIN = false;
    const float* xlo; const float* xhi;
    const float* gate;
    float* X; float* P; int prow0, prows;
    __device__ __forceinline__ void operator()(const f32x4 (&acc)[2][2][4][2], const Unit& u, int wr, int wc, int fr, int fq) const {
        const int rt = u.pm * BM;
        const int cond = rt < 4096 ? 0 : 1 + ((rt - 4096) >> 10);
        const float* xin = rt < 4096 ? xlo : xhi;
        const int row0 = rt + wr * 64 + fr, col0 = u.pn * BM + wc * 32 + 8 * fq;
        f32x4 gv[2][2];
#pragma unroll
        for (int bj = 0; bj < 2; ++bj)
#pragma unroll
            for (int n = 0; n < 2; ++n) gv[bj][n] = *(const f32x4*)(gate + (size_t)cond * 12288 + col0 + bj * HALF + 4 * n);
        if (u.flags & 2) {
            bf16_t* Pk = (bf16_t*)P + ((ptrdiff_t)u.kh * prows - prow0) * 2048;
#pragma unroll
            for (int ai = 0; ai < 2; ++ai)
#pragma unroll
                for (int m = 0; m < 4; ++m) { const size_t off = (size_t)(row0 + ai * HALF + m * 16) * 2048 + col0;
#pragma unroll
                    for (int bj = 0; bj < 2; ++bj) { const f32x4 o0 = gv[bj][0] * acc[ai][bj][m][0], o1 = gv[bj][1] * acc[ai][bj][m][1];
                        u32x4 w; w.x = cvt_pk_bf16(o0[0], o0[1]); w.y = cvt_pk_bf16(o0[2], o0[3]); w.z = cvt_pk_bf16(o1[0], o1[1]); w.w = cvt_pk_bf16(o1[2], o1[3]);
                        *(u32x4*)(Pk + off + bj * HALF) = w; } }
            return;
        }
#pragma unroll
        for (int ai = 0; ai < 2; ++ai)
#pragma unroll
            for (int m = 0; m < 4; ++m) { const size_t off = (size_t)(row0 + ai * HALF + m * 16) * 2048 + col0;
#pragma unroll
                for (int bj = 0; bj < 2; ++bj)
#pragma unroll
                    for (int n = 0; n < 2; ++n) { const f32x4 xv = *(const f32x4*)(xin + off + bj * HALF + 4 * n);
                        *(f32x4*)(X + off + bj * HALF + 4 * n) = xv + gv[bj][n] * acc[ai][bj][m][n]; } }
    }
};
struct SplitOrder {
    int c;
    __host__ __device__ bool next(int i, Unit& u) const {
        if (i >= 3) return false;
        const int x = c & 7, idx = c >> 3;
        if (i < 2) { u.pm = 4 * x + (idx >> 3); u.pn = idx & 7; u.kh = i; u.flags = (i == 0) ? 1 : 0; }
        else { const int tl = idx >> 1; u.pm = 32 + 2 * x + (tl >> 3); u.pn = tl & 7; u.kh = idx & 1; u.flags = 2; }
        return true;
    }
    __device__ __forceinline__ void a_ready(const Unit&) const {}
    __device__ __forceinline__ void done(const Unit&) const {}
};
struct EpiSwiGLU {
    static constexpr bool PERM = true, AFTER_DRAIN = false;
    bf16_t* O; int ldc;
    __device__ __forceinline__ void operator()(const f32x4 (&acc)[2][2][4][2], const Unit& u, int wr, int wc, int fr, int fq) const {
        const int row0 = u.pm * BM + wr * 64 + fr, col0 = u.pn * HALF + wc * 32 + 8 * fq;
#pragma unroll
        for (int ai = 0; ai < 2; ++ai)
#pragma unroll
            for (int m = 0; m < 4; ++m) { const f32x4 g0 = acc[ai][0][m][0], g1 = acc[ai][0][m][1], u0 = acc[ai][1][m][0], u1 = acc[ai][1][m][1];
                u32x4 w;
                w.x = cvt_pk_bf16(g0[0] * sigmoid_f(g0[0]) * u0[0], g0[1] * sigmoid_f(g0[1]) * u0[1]);
                w.y = cvt_pk_bf16(g0[2] * sigmoid_f(g0[2]) * u0[2], g0[3] * sigmoid_f(g0[3]) * u0[3]);
                w.z = cvt_pk_bf16(g1[0] * sigmoid_f(g1[0]) * u1[0], g1[1] * sigmoid_f(g1[1]) * u1[1]);
                w.w = cvt_pk_bf16(g1[2] * sigmoid_f(g1[2]) * u1[2], g1[3] * sigmoid_f(g1[3]) * u1[3]);
                *(u32x4*)(O + (size_t)(row0 + ai * HALF + m * 16) * ldc + col0) = w; }
    }
};

template <class Epi, class Sched, bool ALIGN_EPI = false, bool SP2 = false>
__device__ __forceinline__ void gemm_phase(PG8_LAS unsigned char* lds, const Gemm g, const Sched& S, const Epi& E, const int tid_in) {
    const int tid = tid_in, wid = __builtin_amdgcn_readfirstlane(tid >> 6), lane = tid & 63, wr = wid >> 2, wc = wid & 3, fr = lane & 15, fq = lane >> 4;
    const int K = g.K, nt = K / BK;
    unsigned voffA[2], voffB[2];
#pragma unroll
    for (int i = 0; i < 2; ++i) { int R, C; stage_rc(tid * 16 + i * 8192, R, C); const int Rb = Epi::PERM ? ((R & ~31) + perm32(R & 31)) : R;
        voffA[i] = (unsigned)(R * g.ld + C) * 2u; voffB[i] = (unsigned)(Rb * g.ld + C) * 2u; }
    const size_t kstep = (size_t)(BK * 2);
    const size_t hstep = (size_t)HALF * g.ld * 2;
    const size_t tstep = 2 * hstep;
    const unsigned ldsw = (unsigned)wid * 1024u;
    const int aoff = lds_byte(wr * 64 + fr, fq * 8), boff = lds_byte(wc * 32 + fr, fq * 8);
#define PG8_SA(b, h) (((b) * 2 + (h)) * HTB)
#define PG8_SB(b, h) ((4 + (b) * 2 + (h)) * HTB)
#define PG8_STAGE(bufoff, gbase, voff) do { _Pragma("unroll") for (int _i = 0; _i < 2; ++_i) \
        __builtin_amdgcn_global_load_lds((const unsigned*)((const char*)(gbase) + (voff)[_i]), (PG8_LAS unsigned*)(lds + (bufoff) + ldsw + _i * 8192), 16, 0, 0); } while (0)
#define PG8_LDA(dst, b, h) do { _Pragma("unroll") for (int m = 0; m < 4; ++m) _Pragma("unroll") for (int k = 0; k < 2; ++k) dst[m][k] = *(const PG8_LAS bf16x8*)(lds + PG8_SA(b, h) + aoff + m * 2048 + k * 1024); } while (0)
#define PG8_LDB(dst, b, h) do { _Pragma("unroll") for (int n = 0; n < 2; ++n) _Pragma("unroll") for (int k = 0; k < 2; ++k) dst[n][k] = *(const PG8_LAS bf16x8*)(lds + PG8_SB(b, h) + boff + n * 2048 + k * 1024); } while (0)
#define PG8_MMA(ai, bj, At, Bt) do { __builtin_amdgcn_s_setprio(1); _Pragma("unroll") for (int m = 0; m < 4; ++m) _Pragma("unroll") for (int n = 0; n < 2; ++n) _Pragma("unroll") for (int k = 0; k < 2; ++k) \
        acc[ai][bj][m][n] = __builtin_amdgcn_mfma_f32_16x16x32_bf16(Bt[n][k], At[m][k], acc[ai][bj][m][n], 0, 0, 0); __builtin_amdgcn_s_setprio(0); } while (0)
#define PG8_WAIT_V(n) asm volatile("s_waitcnt vmcnt(" #n ")" ::: "memory")
#define PG8_WAIT_L(n) asm volatile("s_waitcnt lgkmcnt(" #n ")" ::: "memory")
#define PG8_BAR __builtin_amdgcn_s_barrier()
#define PG8_SCHED __builtin_amdgcn_sched_barrier(0)
    Unit cur, nxt; int ui = 0;
    if (!S.next(0, cur)) return;
    f32x4 acc[2][2][4][2];
#pragma unroll
    for (int a = 0; a < 2; ++a)
#pragma unroll
        for (int b = 0; b < 2; ++b)
#pragma unroll
            for (int m = 0; m < 4; ++m)
#pragma unroll
                for (int n = 0; n < 2; ++n) acc[a][b][m][n] = (f32x4){0.f, 0.f, 0.f, 0.f};
    bf16x8 At[4][2], B0[2][2], B1[2][2];
    const size_t khstep = (size_t)K * 2;
    const char* cA = (const char*)g.A + (size_t)cur.pm * tstep + (size_t)cur.kh * khstep; const char* cB = (const char*)g.Bt + (size_t)cur.pn * tstep + (size_t)cur.kh * khstep;
    S.a_ready(cur);
    if constexpr (SP2) {
        PG8_STAGE(PG8_SB(0, 0), cB, voffB); PG8_STAGE(PG8_SB(0, 1), cB + hstep, voffB); PG8_STAGE(PG8_SA(0, 0), cA, voffA); PG8_STAGE(PG8_SA(0, 1), cA + hstep, voffA);
        if (wr == 1) PG8_BAR;
        PG8_WAIT_V(2); PG8_BAR;
        PG8_STAGE(PG8_SB(1, 0), cB + kstep, voffB); PG8_STAGE(PG8_SA(1, 0), cA + kstep, voffA); PG8_STAGE(PG8_SB(1, 1), cB + hstep + kstep, voffB);
        PG8_WAIT_V(6); PG8_BAR;
    } else {
        PG8_STAGE(PG8_SB(0, 0), cB, voffB); PG8_STAGE(PG8_SA(0, 0), cA, voffA); PG8_STAGE(PG8_SB(0, 1), cB + hstep, voffB); PG8_STAGE(PG8_SA(0, 1), cA + hstep, voffA);
        if (wr == 1) PG8_BAR;
        PG8_WAIT_V(4); PG8_BAR;
        PG8_STAGE(PG8_SB(1, 0), cB + kstep, voffB); PG8_STAGE(PG8_SA(1, 0), cA + kstep, voffA); PG8_STAGE(PG8_SB(1, 1), cB + hstep + kstep, voffB);
        PG8_WAIT_V(6); PG8_BAR;
    }
    for (;;) {
        const bool has_next = S.next(ui + 1, nxt);
        const char* nA = has_next ? (const char*)g.A + (size_t)nxt.pm * tstep + (size_t)nxt.kh * khstep : cA; const char* nB = has_next ? (const char*)g.Bt + (size_t)nxt.pn * tstep + (size_t)nxt.kh * khstep : cB;
        for (int t = 0; t < nt; t += 2) {
            const bool last = (t == nt - 2);
            const char* a1 = cA + (size_t)(t + 1) * kstep;
            const char* a2 = last ? nA : cA + (size_t)(t + 2) * kstep; const char* b2 = last ? nB : cB + (size_t)(t + 2) * kstep;
            const char* a3 = a2 + kstep; const char* b3 = b2 + kstep;
            if (last && has_next) S.a_ready(nxt);
            if constexpr (SP2) {
            PG8_LDB(B0, 0, 0); PG8_LDB(B1, 0, 1); PG8_SCHED; PG8_LDA(At, 0, 0); PG8_STAGE(PG8_SA(1, 1), a1 + hstep, voffA);
            PG8_WAIT_V(8); PG8_WAIT_L(0); PG8_BAR; PG8_MMA(0, 0, At, B0); PG8_MMA(0, 1, At, B1); PG8_BAR; PG8_SCHED;
            PG8_LDA(At, 0, 1); PG8_STAGE(PG8_SB(0, 0), b2, voffB); PG8_STAGE(PG8_SB(0, 1), b2 + hstep, voffB); PG8_STAGE(PG8_SA(0, 0), a2, voffA);
            PG8_WAIT_V(8); PG8_WAIT_L(0); PG8_BAR; PG8_MMA(1, 0, At, B0); PG8_MMA(1, 1, At, B1); PG8_BAR; PG8_SCHED;
            PG8_LDB(B0, 1, 0); PG8_LDB(B1, 1, 1); PG8_SCHED; PG8_LDA(At, 1, 0); PG8_STAGE(PG8_SA(0, 1), a2 + hstep, voffA);
            PG8_WAIT_V(8); PG8_WAIT_L(0); PG8_BAR; PG8_MMA(0, 0, At, B0); PG8_MMA(0, 1, At, B1); PG8_BAR; PG8_SCHED;
            PG8_LDA(At, 1, 1); PG8_STAGE(PG8_SB(1, 0), b3, voffB); PG8_STAGE(PG8_SB(1, 1), b3 + hstep, voffB); PG8_STAGE(PG8_SA(1, 0), a3, voffA);
            PG8_WAIT_V(8); PG8_WAIT_L(0); PG8_BAR; PG8_MMA(1, 0, At, B0); PG8_MMA(1, 1, At, B1); PG8_BAR; PG8_SCHED;
            } else {
            PG8_LDB(B0, 0, 0); PG8_SCHED; PG8_LDA(At, 0, 0); PG8_STAGE(PG8_SA(1, 1), a1 + hstep, voffA);
            PG8_WAIT_L(8); PG8_BAR; PG8_WAIT_L(0); PG8_MMA(0, 0, At, B0); PG8_BAR; PG8_SCHED;
            PG8_LDB(B1, 0, 1); PG8_STAGE(PG8_SB(0, 0), b2, voffB);
            PG8_BAR; PG8_WAIT_L(0); PG8_MMA(0, 1, At, B1); PG8_BAR;
            PG8_LDA(At, 0, 1); PG8_STAGE(PG8_SA(0, 0), a2, voffA);
            PG8_BAR; PG8_WAIT_L(0); PG8_MMA(1, 0, At, B0); PG8_BAR; PG8_SCHED;
            PG8_STAGE(PG8_SB(0, 1), b2 + hstep, voffB);
            PG8_WAIT_V(6); PG8_BAR; PG8_MMA(1, 1, At, B1); PG8_BAR;
            PG8_LDB(B0, 1, 0); PG8_SCHED; PG8_LDA(At, 1, 0); PG8_STAGE(PG8_SA(0, 1), a2 + hstep, voffA);
            PG8_WAIT_L(8); PG8_BAR; PG8_WAIT_L(0); PG8_MMA(0, 0, At, B0); PG8_BAR; PG8_SCHED;
            PG8_LDB(B1, 1, 1); PG8_STAGE(PG8_SB(1, 0), b3, voffB);
            PG8_BAR; PG8_WAIT_L(0); PG8_MMA(0, 1, At, B1); PG8_BAR;
            PG8_LDA(At, 1, 1); PG8_STAGE(PG8_SA(1, 0), a3, voffA);
            PG8_BAR; PG8_WAIT_L(0); PG8_MMA(1, 0, At, B0); PG8_BAR; PG8_SCHED;
            PG8_STAGE(PG8_SB(1, 1), b3 + hstep, voffB);
            PG8_WAIT_V(6); PG8_BAR; PG8_MMA(1, 1, At, B1); PG8_BAR;
            }
        }
        if constexpr (ALIGN_EPI) { if (wr == 0) PG8_BAR; }
        const bool keep = (cur.flags & 1) != 0;
        if constexpr (!Epi::AFTER_DRAIN) { if (!keep) { E(acc, cur, wr, wc, fr, fq); S.done(cur); } }
        if (!has_next) break;
        if (!keep) {
#pragma unroll
        for (int a = 0; a < 2; ++a)
#pragma unroll
            for (int b = 0; b < 2; ++b)
#pragma unroll
                for (int m = 0; m < 4; ++m)
#pragma unroll
                    for (int n = 0; n < 2; ++n) acc[a][b][m][n] = (f32x4){0.f, 0.f, 0.f, 0.f};
        }
        cur = nxt; cA = nA; cB = nB; ++ui;
        if constexpr (ALIGN_EPI) { if (wr == 1) PG8_BAR; }
    }
    PG8_WAIT_V(0);
    if constexpr (!ALIGN_EPI) { if (wr == 0) PG8_BAR; }
    PG8_BAR;
    if constexpr (Epi::AFTER_DRAIN) { E.fused(acc, cur, wr, wc, fr, fq, lds, wid, lane); S.done(cur); }
#undef PG8_SA
#undef PG8_SB
#undef PG8_STAGE
#undef PG8_LDA
#undef PG8_LDB
#undef PG8_MMA
#undef PG8_WAIT_V
#undef PG8_WAIT_L
#undef PG8_BAR
#undef PG8_SCHED
}
}

#ifndef MK_ONE_LAUNCH
#define MK_ONE_LAUNCH 1
#endif
constexpr int NWAVES = 8;
constexpr int D = 2048, MCTX = 4096, M = 12288, DIN = 4096, DSSM = 1024, DFF = 5632, NMODC = 12288;
constexpr float EPS = 1e-6f;
constexpr size_t MiB = 1u << 20;
constexpr size_t WS_CTL = 0, CTL_ZERO_BYTES = 64 * 1024;
constexpr size_t WS_MODP = 1 * MiB, WS_MOD = 9 * MiB, WS_TAB = 10 * MiB, WS_E = 11 * MiB;
constexpr size_t WS_WIN = 16 * MiB, WS_WGLU = 48 * MiB, WS_WOUT = 52 * MiB, WS_WGU = 68 * MiB, WS_WDN = 156 * MiB;
constexpr size_t WS_X = 200 * MiB, WS_H = 296 * MiB, WS_CAT = 344 * MiB, WS_Y = 392 * MiB, WS_Z = 416 * MiB, WS_YP = 512 * MiB, WS_ACT = 416 * MiB, WS_P = 548 * MiB, WS_END = 612 * MiB;
constexpr int OUT_STATE = 12288 * 2048;
constexpr int RING_BYTES = 131072, LDSCTL_OFF = RING_BYTES, MISC_OFF = LDSCTL_OFF + 320, LDS_BYTES = 147456;

#define GAS __attribute__((address_space(1)))
#define LAS __attribute__((address_space(3)))
typedef unsigned short bf16;
typedef unsigned v4u __attribute__((ext_vector_type(4)));
typedef unsigned v2u __attribute__((ext_vector_type(2)));
typedef float f32x4 __attribute__((ext_vector_type(4)));
typedef float f32x16 __attribute__((ext_vector_type(16)));
typedef short bf16x8 __attribute__((ext_vector_type(8)));
#define LDS_WAIT() asm volatile("s_waitcnt lgkmcnt(0)" ::: "memory")
#define VM_WAIT() asm volatile("s_waitcnt vmcnt(0)" ::: "memory")
__device__ __forceinline__ unsigned pk2(float lo, float hi) { return pg8::cvt_pk_bf16(lo, hi); }
__device__ __forceinline__ float blo(unsigned w) { return __uint_as_float(w << 16); }
__device__ __forceinline__ float bhi(unsigned w) { return __uint_as_float(w & 0xffff0000u); }

#define XB_TMO      128
#define XB_XCNT(j)  (256  + 64 * (j))
#define XB_XSUB(j)  (1280 + 64 * (j))
#define XB_XGEN(j)  (2304 + 64 * (j))
#define XB_TOP      3328
#define XB_TOPGEN   3392
#define XCD_BAR_WORDS 3456
#define XB_SPIN_CAP (1u << 18)

__device__ __forceinline__ unsigned xb_ld(unsigned* p)              { return __hip_atomic_load(p, __ATOMIC_RELAXED, __HIP_MEMORY_SCOPE_AGENT); }
__device__ __forceinline__ unsigned xb_add(unsigned* p, unsigned v) { return __hip_atomic_fetch_add(p, v, __ATOMIC_RELAXED, __HIP_MEMORY_SCOPE_AGENT); }
__device__ __forceinline__ unsigned xb_xcc_id() { return (unsigned)__builtin_amdgcn_s_getreg((3 << 11) | 20) & 0xFu; }
#define XB_SPIN(cond, bar) do { unsigned _sp = 0; while (cond) { __builtin_amdgcn_s_sleep(1); \
    if ((++_sp & 255u) == 0u) { if (xb_ld(&(bar)[XB_TMO])) break; if (_sp > XB_SPIN_CAP) { atomicAdd(&(bar)[XB_TMO], 1u); break; } } } } while (0)

struct XcdBarrier {
    unsigned* bar; unsigned x;
    volatile LAS unsigned* st;
};

__device__ __forceinline__ XcdBarrier xcd_barrier_post(unsigned* bar, volatile LAS unsigned* st) {
    XcdBarrier b; b.bar = bar; b.x = xb_xcc_id(); b.st = st;
    if (threadIdx.x == 0) (void)xb_add(&bar[XB_XCNT(b.x)], 1u);
    return b;
}
__device__ __forceinline__ void xcd_barrier_complete(unsigned* bar, unsigned x, unsigned& nloc, unsigned& nx) {
    const unsigned G = gridDim.x * gridDim.y * gridDim.z;
    unsigned sum, cnt, mine, sp = 0u;
    for (;;) {
        sum = 0u; cnt = 0u; mine = 0u;
#pragma unroll
        for (unsigned j = 0; j < 16; ++j) { const unsigned c = xb_ld(&bar[XB_XCNT(j)]); sum += c; cnt += (c > 0u) ? 1u : 0u; mine = (j == x) ? c : mine; }
        if (sum == G) break;
        __builtin_amdgcn_s_sleep(1);
        if ((++sp & 255u) == 0u) { if (xb_ld(&bar[XB_TMO])) break; if (sp > XB_SPIN_CAP) { atomicAdd(&bar[XB_TMO], 1u); break; } }
    }
    nloc = mine > 0u ? mine : 1u; nx = cnt > 0u ? cnt : 1u;
}

__device__ __forceinline__ void xcd_barrier(const XcdBarrier& b) {
    asm volatile("s_waitcnt vmcnt(0)" ::: "memory");
    __syncthreads();
    if (threadIdx.x == 0) {
        unsigned* bar = b.bar;
        __builtin_amdgcn_s_waitcnt(0);
        unsigned nloc = b.st[0], nx = b.st[1];
        if (nloc == 0u) { xcd_barrier_complete(bar, b.x, nloc, nx); b.st[0] = nloc; b.st[1] = nx; }
        const unsigned old = xb_add(&bar[XB_XSUB(b.x)], 1u);
        const unsigned gen = old / nloc;
        if (old + 1u == (gen + 1u) * nloc) {
            __builtin_amdgcn_fence(__ATOMIC_RELEASE, "agent");
            asm volatile("s_waitcnt vmcnt(0)" ::: "memory");
            const unsigned og = xb_add(&bar[XB_TOP], 1u);
            const unsigned tg = og / nx;
            if (og + 1u == (tg + 1u) * nx) xb_add(&bar[XB_TOPGEN], 1u);
            else XB_SPIN(xb_ld(&bar[XB_TOPGEN]) == tg, bar);
            __builtin_amdgcn_fence(__ATOMIC_ACQUIRE, "agent");
            xb_add(&bar[XB_XGEN(b.x)], 1u);
            asm volatile("s_waitcnt vmcnt(0)" ::: "memory");
        } else {
            XB_SPIN(xb_ld(&bar[XB_XGEN(b.x)]) == gen, bar);
            __builtin_amdgcn_fence(__ATOMIC_ACQUIRE, "agent");
            asm volatile("s_waitcnt vmcnt(0)" ::: "memory");
        }
    }
    __syncthreads();
}

struct Frame {
    LAS unsigned char* lds;
    volatile LAS unsigned* MISC;
    int tid, lane, wave, G, bx;
};
struct Args { const float* in[26]; float* out; unsigned char* ws; int ph_lo, ph_hi; };
typedef const Args __attribute__((address_space(4)))* KArgs;
__device__ __forceinline__ KArgs get_args() { KArgs p = (KArgs)__builtin_amdgcn_kernarg_segment_ptr(); asm volatile("" : "+s"(p)); return p; }

__device__ __forceinline__ float wave_sum(float v, int lane) {
#pragma unroll
    for (int o = 1; o < 64; o <<= 1) v += __int_as_float(__builtin_amdgcn_ds_bpermute((lane ^ o) << 2, __float_as_int(v)));
    return v;
}

__device__ __forceinline__ void p0_transpose_item(const float* W, int K, int N, bf16* WT, int drow0, LAS float* scr, int k0, int n0, int lane) {
    float wv[32];
#pragma unroll
    for (int i = 0; i < 32; ++i) wv[i] = __builtin_nontemporal_load(W + (size_t)(k0 + 2 * i + (lane >> 5)) * N + n0 + (lane & 31));
#pragma unroll
    for (int i = 0; i < 32; ++i) scr[(2 * i + (lane >> 5)) * 33 + (lane & 31)] = wv[i];
    LDS_WAIT(); asm volatile("" ::: "memory");
    const int c = lane & 7;
#pragma unroll
    for (int j = 0; j < 4; ++j) { const int n = (lane >> 3) + 8 * j; const LAS float* s = scr + (8 * c) * 33 + n;
        v4u o; o.x = pk2(s[0 * 33], s[1 * 33]); o.y = pk2(s[2 * 33], s[3 * 33]); o.z = pk2(s[4 * 33], s[5 * 33]); o.w = pk2(s[6 * 33], s[7 * 33]);
        *(GAS v4u*)(WT + (size_t)(drow0 + n) * K + k0 + 8 * c) = o; }
    LDS_WAIT(); asm volatile("" ::: "memory");
}
constexpr int IT_IN = 32 * 128, IT_GLU = 16 * 32, IT_OUT = 32 * 64, IT_G = 32 * 176, IT_DN = 88 * 64;
constexpr int IT_LAYER = IT_IN + IT_GLU + IT_OUT + 2 * IT_G + IT_DN;
constexpr int IT_TOTAL = 2 * IT_LAYER;
constexpr int IT_EARLY = IT_IN + IT_GLU + IT_OUT;
__device__ __forceinline__ void p0_item(KArgs a, LAS float* scr, int it, int lane) {
    const int l = it / IT_LAYER; int r = it - l * IT_LAYER;
    unsigned char* ws = a->ws;
    if (r < IT_IN) { const int kb = r / 128, nb = r % 128;
        p0_transpose_item(a->in[8] + (size_t)l * 2048 * 4096, 2048, 4096, (bf16*)(ws + WS_WIN) + (size_t)l * 4096 * 2048, 32 * nb, scr, 64 * kb, 32 * nb, lane); return; } r -= IT_IN;
    if (r < IT_GLU) { const int kb = r / 32, nb = r % 32;
        p0_transpose_item(a->in[17] + (size_t)l * 1024 * 1024, 1024, 1024, (bf16*)(ws + WS_WGLU) + (size_t)l * 1024 * 1024, 32 * nb, scr, 64 * kb, 32 * nb, lane); return; } r -= IT_GLU;
    if (r < IT_OUT) { const int kb = r / 64, nb = r % 64;
        p0_transpose_item(a->in[20] + (size_t)l * 2048 * 2048, 2048, 2048, (bf16*)(ws + WS_WOUT) + (size_t)l * 2048 * 2048, 32 * nb, scr, 64 * kb, 32 * nb, lane); return; } r -= IT_OUT;
    if (r < 2 * IT_G) { const int up = r >= IT_G; if (up) r -= IT_G; const int kb = r / 176, nb = r % 176, n0 = 32 * nb;
        p0_transpose_item(a->in[up ? 23 : 22] + (size_t)l * 2048 * 5632, 2048, 5632, (bf16*)(ws + WS_WGU) + (size_t)l * 11264 * 2048, (n0 >> 7) * 256 + (n0 & 127) + (up ? 128 : 0), scr, 64 * kb, n0, lane); return; } r -= 2 * IT_G;
    { const int kb = r / 64, nb = r % 64;
        p0_transpose_item(a->in[24] + (size_t)l * 5632 * 2048, 5632, 2048, (bf16*)(ws + WS_WDN) + (size_t)l * 2048 * 5632, 32 * nb, scr, 64 * kb, 32 * nb, lane); }
}
constexpr int MOD_TASKS = 2 * 96 * 8;
__device__ __forceinline__ void p0_mod_task(KArgs a, LAS float* scr, int task, int lane) {
    const int ks = task & 7, cgp = (task >> 3) % 96, l = task / 768;
    const int kb = ks * 256;
    const float* cin = a->in[3]; const float* cctx = a->in[4];
#pragma unroll
    for (int i = 0; i < 4; ++i) { const int kk = lane + 64 * i;
#pragma unroll
        for (int c = 0; c < 9; ++c) { const float v = c == 0 ? cctx[kb + kk] : cin[(c - 1) * 2048 + kb + kk]; scr[c * 256 + kk] = v * __builtin_amdgcn_rcpf(1.0f + __expf(-v)); } }
    LDS_WAIT(); asm volatile("" ::: "memory");
    const float* w = a->in[5] + ((size_t)l * 2048 + kb) * NMODC + cgp * 128 + 2 * lane;
    pg8::f32x2 acc[9];
#pragma unroll
    for (int c = 0; c < 9; ++c) acc[c] = (pg8::f32x2){0.f, 0.f};
    for (int kk = 0; kk < 256; kk += 8) {
        pg8::f32x2 wv[8];
#pragma unroll
        for (int j = 0; j < 8; ++j) wv[j] = __builtin_nontemporal_load((const pg8::f32x2*)(w + (size_t)(kk + j) * NMODC));
#pragma unroll
        for (int j = 0; j < 8; ++j)
#pragma unroll
            for (int c = 0; c < 9; ++c) acc[c] += scr[c * 256 + kk + j] * wv[j];
    }
    LDS_WAIT(); asm volatile("" ::: "memory");
#pragma unroll
    for (int c = 0; c < 9; ++c) *(LAS pg8::f32x2*)((LAS unsigned char*)scr + c * 512 + lane * 8) = acc[c];
}
__device__ __forceinline__ void p0_mod_finish(KArgs a, LAS unsigned char* lds0, int task, int wave, int lane) {
    const int cgp = (task >> 3) % 96, l = task / 768;
    for (int c = wave; c < 9; c += 8) {
        pg8::f32x2 s = *(const pg8::f32x2*)(a->in[6] + (size_t)l * NMODC + cgp * 128 + 2 * lane);
#pragma unroll
        for (int ks = 0; ks < 8; ++ks) s += *(const LAS pg8::f32x2*)(lds0 + ks * 16384 + c * 512 + lane * 8);
        *(pg8::f32x2*)((float*)(a->ws + WS_MOD) + ((size_t)l * 9 + c) * NMODC + cgp * 128 + 2 * lane) = s;
    }
}
__device__ __forceinline__ void sincos_f(float x, float& s, float& c) {
    const float q = rintf(x * 0.636619772367581343f);
    float r = fmaf(-q, 1.57079637050628662109375f, x); r = fmaf(-q, -4.37113900018624283e-8f, r);
    const float r2 = r * r;
    float sp = fmaf(r2, 2.7557319e-6f, -1.9841270e-4f); sp = fmaf(sp, r2, 8.3333333e-3f); sp = fmaf(sp, r2, -1.6666667e-1f); sp = fmaf(sp * r2, r, r);
    float cp = fmaf(r2, -2.7557319e-7f, 2.4801587e-5f); cp = fmaf(cp, r2, -1.3888889e-3f); cp = fmaf(cp, r2, 4.1666667e-2f); cp = fmaf(cp, r2, -0.5f); cp = fmaf(cp, r2, 1.0f);
    const int qi = (int)q & 3;
    s = (qi == 0) ? sp : (qi == 1) ? cp : (qi == 2) ? -sp : -cp;
    c = (qi == 0) ? cp : (qi == 1) ? -sp : (qi == 2) ? -cp : sp;
}
__device__ __forceinline__ void p0_ssm_tab(KArgs a, int idx) {
    const int ldg = idx >> 6;
    const float lre = fminf(a->in[9][idx], -1e-4f), lim = a->in[10][idx];
    const float dt = __expf(a->in[11][ldg]);
    const float x = lre * dt, y = lim * dt;
    float em1;
    if (fabsf(x) < 0.25f) { float t = fmaf(x, 1.0f / 5040.0f, 1.0f / 720.0f); t = fmaf(t, x, 1.0f / 120.0f); t = fmaf(t, x, 1.0f / 24.0f); t = fmaf(t, x, 1.0f / 6.0f); t = fmaf(t, x, 0.5f); t = fmaf(t, x, 1.0f); em1 = t * x; }
    else em1 = __expf(x) - 1.0f;
    const float ex = 1.0f + em1;
    float sy, cy, sh, ch; sincos_f(y, sy, cy); sincos_f(0.5f * y, sh, ch);
    const float are = ex * cy, aim = ex * sy;
    const float nre = fmaf(em1, cy, -2.0f * sh * sh), nim = aim;
    const float den = __builtin_amdgcn_rcpf(lre * lre + lim * lim);
    f32x4 o; o.x = are; o.y = aim; o.z = (nre * lre + nim * lim) * den; o.w = (nim * lre - nre * lim) * den;
    ((f32x4*)(a->ws + WS_TAB))[idx] = o;
}
__device__ __forceinline__ void p0_prologue(Frame& F, KArgs a) {
    LAS float* scr = (LAS float*)(F.lds + F.wave * 16384);
    const int gw = F.bx * NWAVES + F.wave, NGW = F.G * NWAVES;
    const int gt = F.bx * (NWAVES * 64) + F.tid;
    for (int i = gt; i < 16384; i += NGW * 64) p0_ssm_tab(a, i);
    constexpr int NIT = IT_IN;
    int nmodw = NGW > MOD_TASKS ? MOD_TASKS : 0;
    if (nmodw == 0) { for (int t = gw; t < MOD_TASKS; t += NGW) { p0_mod_task(a, scr, t, F.lane); LDS_WAIT(); __syncthreads(); p0_mod_finish(a, F.lds, t, F.wave, F.lane); LDS_WAIT(); __syncthreads(); } for (int it = gw; it < NIT; it += NGW) p0_item(a, scr, it, F.lane); return; }
    int share = (NIT + 16 * MOD_TASKS) / NGW - 16; if (share < 0) share = 0;
    const int rest = NIT - share * nmodw, nother = NGW - nmodw, per = (rest + nother - 1) / nother;
    int lo, hi;
    if (gw < nmodw) { p0_mod_task(a, scr, gw, F.lane); LDS_WAIT(); __syncthreads(); p0_mod_finish(a, F.lds, gw, F.wave, F.lane); LDS_WAIT(); __syncthreads(); lo = gw * share; hi = lo + share; }
    else { lo = share * nmodw + (gw - nmodw) * per; hi = lo + per; if (hi > NIT) hi = NIT; }
    for (int it = lo; it < hi; ++it) p0_item(a, scr, it, F.lane);
}
__device__ __forceinline__ void p1_mod_reduce(Frame& F, KArgs a) {
    const int gt = F.bx * (NWAVES * 64) + F.tid, NT = F.G * NWAVES * 64;
    const f32x4* P = (const f32x4*)(a->ws + WS_MODP); f32x4* O = (f32x4*)(a->ws + WS_MOD);
    constexpr int N4 = 2 * 9 * NMODC / 4, J4 = NMODC / 4;
    for (int i = gt; i < N4; i += NT) { const int l = i / (9 * J4), j4 = i % J4;
        f32x4 s = ((const f32x4*)(a->in[6]))[l * J4 + j4];
#pragma unroll
        for (int ks = 0; ks < 8; ++ks) s += P[(size_t)ks * N4 + i];
        O[i] = s; }
}

__device__ __forceinline__ int cond_of(int row) { return row < MCTX ? 0 : 1 + ((row - MCTX) >> 10); }
__device__ __forceinline__ void norm_mod_phase(Frame& F, const float* xlo, const float* xhi, const float* g, const float* modl, int sh_i, int sc_i, bf16* H, const float* P, float* Xw) {
    const int gw = F.bx * NWAVES + F.wave, NGW = F.G * NWAVES;
    for (int row = gw; row < M; row += NGW) {
        const f32x4* xr = (const f32x4*)((row < MCTX ? xlo : xhi) + (size_t)row * D) + F.lane;
        f32x4 v[8]; float s = 0.f;
        if (P && row >= 8192) {
            const v2u* p0 = (const v2u*)((const bf16*)P + (size_t)(row - 8192) * D) + F.lane; const v2u* p1 = p0 + (size_t)4096 * D / 4;     f32x4* xw = (f32x4*)(Xw + (size_t)row * D) + F.lane;
#pragma unroll
            for (int j = 0; j < 8; ++j) { { const v2u q0 = p0[64 * j], q1 = p1[64 * j]; v[j] = xr[64 * j] + (f32x4){blo(q0.x), bhi(q0.x), blo(q0.y), bhi(q0.y)} + (f32x4){blo(q1.x), bhi(q1.x), blo(q1.y), bhi(q1.y)}; } xw[64 * j] = v[j]; s += (v[j].x * v[j].x + v[j].y * v[j].y) + (v[j].z * v[j].z + v[j].w * v[j].w); }
        } else {
#pragma unroll
        for (int j = 0; j < 8; ++j) { v[j] = xr[64 * j]; s += (v[j].x * v[j].x + v[j].y * v[j].y) + (v[j].z * v[j].z + v[j].w * v[j].w); }
        }
        const float rstd = __builtin_amdgcn_rsqf(wave_sum(s, F.lane) * (1.0f / D) + EPS);
        const float* mc = modl + (size_t)cond_of(row) * NMODC;
        const f32x4* g4 = (const f32x4*)g + F.lane; const f32x4* sc4 = (const f32x4*)(mc + sc_i * D) + F.lane; const f32x4* sh4 = (const f32x4*)(mc + sh_i * D) + F.lane;
        v2u* o = (v2u*)(H + (size_t)row * D) + F.lane;
#pragma unroll
        for (int j = 0; j < 8; ++j) { const f32x4 y = (v[j] * rstd) * g4[64 * j]; const f32x4 h = y * (1.0f + sc4[64 * j]) + sh4[64 * j];
            v2u w; w.x = pk2(h.x, h.y); w.y = pk2(h.z, h.w); o[64 * j] = w; }
    }
}
__device__ __forceinline__ void final_norm_phase(Frame& F, const float* X, const float* g, float* out, const float* P) {
    const int gw = F.bx * NWAVES + F.wave, NGW = F.G * NWAVES;
    for (int row = gw; row < M; row += NGW) {
        const f32x4* xr = (const f32x4*)(X + (size_t)row * D) + F.lane;
        f32x4 v[8]; float s = 0.f;
        if (P && row >= 8192) {
            const v2u* p0 = (const v2u*)((const bf16*)P + (size_t)(row - 8192) * D) + F.lane; const v2u* p1 = p0 + (size_t)4096 * D / 4;
#pragma unroll
            for (int j = 0; j < 8; ++j) { { const v2u q0 = p0[64 * j], q1 = p1[64 * j]; v[j] = xr[64 * j] + (f32x4){blo(q0.x), bhi(q0.x), blo(q0.y), bhi(q0.y)} + (f32x4){blo(q1.x), bhi(q1.x), blo(q1.y), bhi(q1.y)}; } s += (v[j].x * v[j].x + v[j].y * v[j].y) + (v[j].z * v[j].z + v[j].w * v[j].w); }
        } else {
#pragma unroll
        for (int j = 0; j < 8; ++j) { v[j] = xr[64 * j]; s += (v[j].x * v[j].x + v[j].y * v[j].y) + (v[j].z * v[j].z + v[j].w * v[j].w); }
        }
        const float rstd = __builtin_amdgcn_rsqf(wave_sum(s, F.lane) * (1.0f / D) + EPS);
        const f32x4* g4 = (const f32x4*)g + F.lane; f32x4* o = (f32x4*)(out + (size_t)row * D) + F.lane;
#pragma unroll
        for (int j = 0; j < 8; ++j) __builtin_nontemporal_store((v[j] * rstd) * g4[64 * j], o + 64 * j);
    }
}
__device__ __forceinline__ float gelu_tanh(float x) { const float t = 1.5957691216057308f * fmaf(0.044715f * x * x, x, x); return x * __builtin_amdgcn_rcpf(1.0f + __expf(-t)); }
__device__ __forceinline__ void conv_row(KArgs a, int l, int row, int lane) {
    const bf16* Z = (const bf16*)(a->ws + WS_Z); bf16* CAT = (bf16*)(a->ws + WS_CAT);
    const float* cw = a->in[18] + (size_t)l * 3 * 1024; const float* cb = a->in[19] + (size_t)l * 1024;
    const int t = row < MCTX ? (row & 255) : ((row - MCTX) & 63), Lc = row < MCTX ? 256 : 64;
    const bool hp = t > 0, hn = t < Lc - 1;
    const bf16* zr = Z + (size_t)row * DIN;
    v4u gc[2], vv[2], gb[2], gcp[2], vp[2], gcn[2], vn[2];
#pragma unroll
    for (int hc = 0; hc < 2; ++hc) {
        const int c0 = hc * 512 + lane * 8;
        gc[hc] = *(const v4u*)(zr + 2048 + c0); vv[hc] = *(const v4u*)(zr + 3072 + c0); gb[hc] = *(const v4u*)(zr + 1024 + c0);
        gcp[hc] = (v4u){0u, 0u, 0u, 0u}; vp[hc] = gcp[hc]; gcn[hc] = gcp[hc]; vn[hc] = gcp[hc];
        if (hp) { gcp[hc] = *(const v4u*)(zr - DIN + 2048 + c0); vp[hc] = *(const v4u*)(zr - DIN + 3072 + c0); }
        if (hn) { gcn[hc] = *(const v4u*)(zr + DIN + 2048 + c0); vn[hc] = *(const v4u*)(zr + DIN + 3072 + c0); }
    }
#pragma unroll
    for (int hc = 0; hc < 2; ++hc) {
        const int c0 = hc * 512 + lane * 8;
        unsigned ow[4];
#pragma unroll
        for (int q = 0; q < 4; ++q) {
            const int c = c0 + 2 * q;
            const float z0 = blo(gc[hc][q]) * blo(vv[hc][q]), z1 = bhi(gc[hc][q]) * bhi(vv[hc][q]);
            const float p0 = blo(gcp[hc][q]) * blo(vp[hc][q]), p1 = bhi(gcp[hc][q]) * bhi(vp[hc][q]);
            const float n0 = blo(gcn[hc][q]) * blo(vn[hc][q]), n1 = bhi(gcn[hc][q]) * bhi(vn[hc][q]);
            const float r0 = cw[c] * p0 + cw[1024 + c] * z0 + cw[2048 + c] * n0 + cb[c];
            const float r1 = cw[c + 1] * p1 + cw[1024 + c + 1] * z1 + cw[2048 + c + 1] * n1 + cb[c + 1];
            ow[q] = pk2(blo(gb[hc][q]) * r0, bhi(gb[hc][q]) * r1);
        }
        *(v4u*)(CAT + (size_t)row * D + 1024 + c0) = (v4u){ow[0], ow[1], ow[2], ow[3]};
    }
}
__device__ __forceinline__ void combine_row(KArgs a, int l, int row, int lane) {
    const bf16* Z = (const bf16*)(a->ws + WS_Z); bf16* Y = (bf16*)(a->ws + WS_Y); const float* YP = (const float*)(a->ws + WS_YP);
    const float* dsk = a->in[16] + (size_t)l * 1024;
    const bf16* zr = Z + (size_t)row * DIN;
#pragma unroll
    for (int hc = 0; hc < 2; ++hc) {
        const int c0 = hc * 512 + lane * 8;
        const v4u uu = *(const v4u*)(zr + c0);
        const f32x4 a0 = *(const f32x4*)(YP + (size_t)row * 1024 + c0), a1 = *(const f32x4*)(YP + (size_t)row * 1024 + c0 + 4);
        const f32x4 b0 = *(const f32x4*)(YP + (size_t)(M + row) * 1024 + c0), b1 = *(const f32x4*)(YP + (size_t)(M + row) * 1024 + c0 + 4);
        const f32x4 d0 = *(const f32x4*)(dsk + c0), d1 = *(const f32x4*)(dsk + c0 + 4);
        f32x4 y0, y1;
        y0.x = a0.x + b0.x + d0.x * blo(uu.x); y0.y = a0.y + b0.y + d0.y * bhi(uu.x); y0.z = a0.z + b0.z + d0.z * blo(uu.y); y0.w = a0.w + b0.w + d0.w * bhi(uu.y);
        y1.x = a1.x + b1.x + d1.x * blo(uu.z); y1.y = a1.y + b1.y + d1.y * bhi(uu.z); y1.z = a1.z + b1.z + d1.z * blo(uu.w); y1.w = a1.w + b1.w + d1.w * bhi(uu.w);
        v4u yo; yo.x = pk2(gelu_tanh(y0.x), gelu_tanh(y0.y)); yo.y = pk2(gelu_tanh(y0.z), gelu_tanh(y0.w)); yo.z = pk2(gelu_tanh(y1.x), gelu_tanh(y1.y)); yo.w = pk2(gelu_tanh(y1.z), gelu_tanh(y1.w));
        *(v4u*)(Y + (size_t)row * 1024 + c0) = yo;
    }
}
__device__ __forceinline__ void combine_phase(Frame& F, KArgs a, int l) {
    const int gw = F.bx * NWAVES + F.wave, NGW = F.G * NWAVES;
    const int row_lo = NGW > 10 * 128 + 64 ? MCTX : 0;
    for (int row = row_lo + gw; row < M; row += NGW) combine_row(a, l, row, F.lane);
}
constexpr int SIDE_LDS_OFF = 40960;
__device__ __forceinline__ void ssm_side_work(Frame& F, KArgs a, int l, int pass) {
    const int vw = F.wave == 4 ? 7 : F.wave == 7 ? 4 : F.wave;
    const int NGW = F.G * NWAVES, gwi = vw * F.G + F.bx;
    const int ntask = pass == 0 ? 10 * 128 : 6 * 128;
    int sw, NSW;
    if (NGW <= 10 * 128 + 64) { sw = F.bx * NWAVES + F.wave; NSW = NGW; }
    else { if (gwi < ntask) return; sw = gwi - ntask; NSW = NGW - ntask; }
    LAS float* scr = (LAS float*)(F.lds + SIDE_LDS_OFF + F.wave * 8448);
    const int idle0 = NGW > 10 * 128 + 64 ? NGW - 10 * 128 : NGW, idle1 = NGW > 10 * 128 + 64 ? NGW - 6 * 128 : NGW;
    const int R0 = l == 0 ? (M * 3) / 4 : (int)(((long)M * idle0) / (idle0 + idle1));
    constexpr int NG2 = 4000, NI0 = NG2 + 1500, NIS = IT_LAYER - IT_EARLY;
    if (pass == 0) { for (int row = sw; row < R0; row += NSW) conv_row(a, l, row, F.lane);
        if (l == 0) { for (int it = IT_IN + sw; it < IT_EARLY; it += NSW) p0_item(a, scr, it, F.lane);
            for (int it = NG2 + sw; it < NI0; it += NSW) p0_item(a, scr, IT_EARLY + it, F.lane); } }
    else { for (int row = R0 + sw; row < M; row += NSW) conv_row(a, l, row, F.lane);
        if (NGW > 10 * 128 + 64) for (int row = sw; row < MCTX; row += NSW) combine_row(a, l, row, F.lane);
        if (l == 0) for (int it = NI0 + sw; it < NIS; it += NSW) p0_item(a, scr, IT_EARLY + it, F.lane); }
}

constexpr int SSM_ROWB = 272, SSM_SCR = 16 * SSM_ROWB;
constexpr int SSM_TASKS0 = 10 * 128, SSM_TASKS1 = 6 * 128;
__device__ __forceinline__ void ssm_phase(Frame& F, KArgs a, int l, int pass) {
    LAS unsigned char* scr = F.lds + F.wave * SSM_SCR;
    const int lane = F.lane, c = lane & 15, r = lane >> 4;
    const int vw = F.wave == 4 ? 7 : F.wave == 7 ? 4 : F.wave;
    const int gwi = vw * F.G + F.bx, NGW = F.G * NWAVES;
    const bf16* Z = (const bf16*)(a->ws + WS_Z); float* YP = (float*)(a->ws + WS_YP);
    const f32x4* TAB = (const f32x4*)(a->ws + WS_TAB);
    float* EB = (float*)(a->ws + WS_E);
    const int ntask = pass == 0 ? SSM_TASKS0 : SSM_TASKS1;
    __builtin_amdgcn_s_setprio(3);
    for (int task = gwi; task < ntask; task += NGW) {
        const int q = task >> 7, t_ = task & 127, d = t_ & 1, g = t_ >> 1;
        bool lat, local = false; int k = 0, b;
        if (pass == 0) { if (q < 4) { lat = false; b = 4 * q + r; } else if (q < 6) { lat = true; k = 0; b = 4 * (q - 4) + r; } else { lat = true; local = true; k = 1 + ((q - 6) >> 1); b = 4 * ((q - 6) & 1) + r; } }
        else { lat = true; k = 1 + (q >> 1); b = 4 * (q & 1) + r; }
        const int L = lat ? 1024 : 256, P0 = 256 * k;
        const int b0 = b - r;
        const int rowbase0 = lat ? MCTX + b0 * 1024 : b0 * 256;
        const int ldg = (l * 2 + d) * 64 + g;
        float ar[4], ai[4], sr[4], si[4];
        bf16x8 Bop[8], Cm[4];
#pragma unroll
        for (int t = 0; t < 4; ++t) {
            const f32x4 tb = TAB[ldg * 64 + c + 16 * t]; ar[t] = tb.x; ai[t] = tb.y;
            v4u wre = (v4u){0u, 0u, 0u, 0u}, wim = wre;
            if (r < 2) {
                const float* br = a->in[12] + ((size_t)ldg * 64 + c + 16 * t) * 16 + 8 * r; const float* bi = a->in[13] + ((size_t)ldg * 64 + c + 16 * t) * 16 + 8 * r;
                const f32x4 r0 = *(const f32x4*)br, r1 = *(const f32x4*)(br + 4), i0 = *(const f32x4*)bi, i1 = *(const f32x4*)(bi + 4);
                const f32x4 re0 = tb.z * r0 - tb.w * i0, re1 = tb.z * r1 - tb.w * i1, im0 = tb.z * i0 + tb.w * r0, im1 = tb.z * i1 + tb.w * r1;
                wre.x = pk2(re0.x, re0.y); wre.y = pk2(re0.z, re0.w); wre.z = pk2(re1.x, re1.y); wre.w = pk2(re1.z, re1.w);
                wim.x = pk2(im0.x, im0.y); wim.y = pk2(im0.z, im0.w); wim.z = pk2(im1.x, im1.y); wim.w = pk2(im1.z, im1.w);
            }
            Bop[2 * t] = __builtin_bit_cast(bf16x8, wre); Bop[2 * t + 1] = __builtin_bit_cast(bf16x8, wim);
            sr[t] = 0.f; si[t] = 0.f;
            const int p = c + 16 * t;
            if (lat && k == 0) { const float* st = a->in[2] + (size_t)(((b * 2 + l) * 2 + d) * 2) * 4096 + g * 64; sr[t] = st[p]; si[t] = st[4096 + p]; }
            if (pass == 1) {
                float pr = ar[t], pi = ai[t];
#pragma unroll
                for (int e = 0; e < 8; ++e) { const float nr = pr * pr - pi * pi, ni = 2.f * pr * pi; pr = nr; pi = ni; }
                const float* e0 = EB + ((size_t)((b * 3 + 0) * 2 + d) * 64 + g) * 128;
                float cr_ = e0[p], ci_ = e0[64 + p];
                if (k >= 2) { const float* e1 = EB + ((size_t)((b * 3 + 1) * 2 + d) * 64 + g) * 128; const float nr = pr * cr_ - pi * ci_ + e1[p], ni = pr * ci_ + pi * cr_ + e1[64 + p]; cr_ = nr; ci_ = ni; }
                if (k >= 3) { const float* e2 = EB + ((size_t)((b * 3 + 2) * 2 + d) * 64 + g) * 128; const float nr = pr * cr_ - pi * ci_ + e2[p], ni = pr * ci_ + pi * cr_ + e2[64 + p]; cr_ = nr; ci_ = ni; }
                sr[t] = cr_; si[t] = ci_;
            }
        }
#pragma unroll
        for (int ks = 0; ks < 4; ++ks) { const int p = 16 * ks + 4 * r;
            const f32x4 cr = *(const f32x4*)(a->in[14] + ((size_t)ldg * 16 + c) * 64 + p), ci = *(const f32x4*)(a->in[15] + ((size_t)ldg * 16 + c) * 64 + p);
            v4u w; w.x = pk2(cr.x, -ci.x); w.y = pk2(cr.y, -ci.y); w.z = pk2(cr.z, -ci.z); w.w = pk2(cr.w, -ci.w); Cm[ks] = __builtin_bit_cast(bf16x8, w); }
        const int seqA = c >> 2, tokA = c & 3;
        const bf16* zA = Z + (size_t)(rowbase0 + seqA * L) * DIN + 16 * g + 8 * (r & 1);
        float* yp = YP + (size_t)d * M * 1024 + (size_t)(rowbase0 + seqA * L) * 1024 + 16 * g + 4 * r;
        f32x4 z4 = (f32x4){0.f, 0.f, 0.f, 0.f}; asm volatile("" : "+v"(z4));
        const bf16x8 zero8 = (bf16x8){0, 0, 0, 0, 0, 0, 0, 0};
        constexpr int nblk = 16;
        bf16x8 Ab[4], An[4];
#pragma unroll
        for (int s4 = 0; s4 < 4; ++s4) { const int pos = P0 + 4 * s4 + tokA, tt = d ? L - 1 - pos : pos; Ab[s4] = zero8; if (r < 2) Ab[s4] = *(const bf16x8*)(zA + (size_t)tt * DIN); }
        const unsigned wbase = (unsigned)((4 * r) * SSM_ROWB + 4 * c), rbase = (unsigned)(c * SSM_ROWB + 16 * r);
        for (int blk = 0; blk < nblk; ++blk) {
#pragma unroll
            for (int s4 = 0; s4 < 4; ++s4) { An[s4] = Ab[s4];
                if (blk + 1 < nblk && r < 2) { const int pos = P0 + 16 * (blk + 1) + 4 * s4 + tokA, tt = d ? L - 1 - pos : pos; An[s4] = *(const bf16x8*)(zA + (size_t)tt * DIN); } }
#pragma unroll
            for (int s4 = 0; s4 < 4; ++s4) {
                f32x4 D[8];
#pragma unroll
                for (int j = 0; j < 8; ++j) D[j] = __builtin_amdgcn_mfma_f32_16x16x32_bf16(Ab[s4], Bop[j], z4, 0, 0, 0);
                if (local) {
#pragma unroll
                    for (int i = 0; i < 4; ++i)
#pragma unroll
                        for (int t = 0; t < 4; ++t) {
                            const float nr = fmaf(ar[t], sr[t], fmaf(-ai[t], si[t], D[2 * t][i])), ni = fmaf(ar[t], si[t], fmaf(ai[t], sr[t], D[2 * t + 1][i]));
                            sr[t] = nr; si[t] = ni; }
                } else {
#pragma unroll
                for (int i = 0; i < 4; ++i) {
#pragma unroll
                    for (int t = 0; t < 4; ++t) {
                        const float nr = fmaf(ar[t], sr[t], fmaf(-ai[t], si[t], D[2 * t][i])), ni = fmaf(ar[t], si[t], fmaf(ai[t], sr[t], D[2 * t + 1][i]));
                        sr[t] = nr; si[t] = ni;
                        *(LAS unsigned*)(scr + wbase + i * SSM_ROWB + 64 * t) = pk2(nr, ni);
                    }
                }
                LDS_WAIT(); __builtin_amdgcn_wave_barrier(); asm volatile("" ::: "memory");
                f32x4 y, yb;
                { const bf16x8 f0 = *(const LAS bf16x8*)(scr + rbase), f1 = *(const LAS bf16x8*)(scr + rbase + 64), f2 = *(const LAS bf16x8*)(scr + rbase + 128), f3 = *(const LAS bf16x8*)(scr + rbase + 192);
                  y = __builtin_amdgcn_mfma_f32_16x16x32_bf16(Cm[0], f0, z4, 0, 0, 0); yb = __builtin_amdgcn_mfma_f32_16x16x32_bf16(Cm[1], f1, z4, 0, 0, 0);
                  y = __builtin_amdgcn_mfma_f32_16x16x32_bf16(Cm[2], f2, y, 0, 0, 0); yb = __builtin_amdgcn_mfma_f32_16x16x32_bf16(Cm[3], f3, yb, 0, 0, 0); y = y + yb; }
                { const int pos = P0 + 16 * blk + 4 * s4 + tokA, tt = d ? L - 1 - pos : pos; *(f32x4*)(yp + (size_t)tt * 1024) = y; }
                LDS_WAIT(); __builtin_amdgcn_wave_barrier(); asm volatile("" ::: "memory");
                }
            }
#pragma unroll
            for (int s4 = 0; s4 < 4; ++s4) Ab[s4] = An[s4];
        }
        if (!lat) { float* so = a->out + OUT_STATE + (size_t)(((b * 2 + l) * 2 + d) * 2) * 4096 + g * 64;
#pragma unroll
            for (int t = 0; t < 4; ++t) { so[c + 16 * t] = sr[t]; so[4096 + c + 16 * t] = si[t]; } }
        else if (pass == 0) { float* eo = EB + ((size_t)((b * 3 + k) * 2 + d) * 64 + g) * 128;
#pragma unroll
            for (int t = 0; t < 4; ++t) { eo[c + 16 * t] = sr[t]; eo[64 + c + 16 * t] = si[t]; } }
    }
    __builtin_amdgcn_s_setprio(0);
}

constexpr int NPH = 23;
__global__ void __launch_bounds__(NWAVES * 64, 2) fwd_megakernel(Args args_unused) {
    extern __shared__ __attribute__((aligned(16))) unsigned char lds[];
    for (int u = threadIdx.x; u < (LDS_BYTES - LDSCTL_OFF) / 4; u += NWAVES * 64) ((LAS unsigned*)((LAS unsigned char*)lds + LDSCTL_OFF))[u] = 0u;
    __syncthreads();
    int lo, hi;
    { KArgs a0 = get_args(); lo = a0->ph_lo; hi = a0->ph_hi;
      if (lo < 0) cooperative_groups::this_grid().sync();
      if (hi - lo > 1) (void)xcd_barrier_post((unsigned*)(a0->ws + WS_CTL), (volatile LAS unsigned*)((LAS unsigned char*)lds + MISC_OFF) + 8); }
#pragma unroll 1
    for (int ph = lo; ph < hi; ++ph) {
        KArgs a = get_args();
        Frame F;
        { int t = threadIdx.x; asm volatile("" : "+v"(t)); int gsz = gridDim.x; asm volatile("" : "+s"(gsz)); int bx = blockIdx.x; asm volatile("" : "+s"(bx));
          F.lds = (LAS unsigned char*)lds; F.MISC = (volatile LAS unsigned*)(F.lds + MISC_OFF);
          F.tid = t; F.lane = t & 63; F.wave = __builtin_amdgcn_readfirstlane(t >> 6); F.G = gsz; F.bx = bx; }
        unsigned char* ws = a->ws;
        const int l = ph >= 12 ? 1 : 0, kk = ph - 2 - 10 * l, k = kk <= 2 ? kk : kk - 1;
        float* X = (float*)(ws + WS_X); bf16* H = (bf16*)(ws + WS_H); bf16* CAT = (bf16*)(ws + WS_CAT); bf16* Yb = (bf16*)(ws + WS_Y);
        const float* modl = (const float*)(ws + WS_MOD) + (size_t)l * 9 * NMODC;
        if (ph == 0) p0_prologue(F, a);
        else if (ph == 1) continue;
        else if (ph == 22) final_norm_phase(F, X, a->in[25], a->out, F.G == 256 ? (const float*)(ws + WS_P) : nullptr);
        else if (k == 0 || k == 6) {
            const bool inp = (k == 0 && l == 0);
            const float* xlo = inp ? a->in[0] : X; const float* xhi = inp ? a->in[1] - (size_t)MCTX * D : X;
            norm_mod_phase(F, xlo, xhi, a->in[k == 0 ? 7 : 21] + (size_t)l * D, modl, k == 0 ? 0 : 3, k == 0 ? 1 : 4, H, (k == 0 && l == 1 && F.G == 256) ? (const float*)(ws + WS_P) : nullptr, X);
        }
        else if (k == 1) { pg8::Gemm g{H, (const bf16*)(ws + WS_WIN) + (size_t)l * 4096 * 2048, M, DIN, D, D}; pg8::StaticOrder S; S.init(M, DIN, F.G, F.bx);
            pg8::EpiStoreBf16 E{(bf16*)(ws + WS_Z), DIN}; pg8::gemm_phase<pg8::EpiStoreBf16, pg8::StaticOrder, true, true>(F.lds, g, S, E, F.tid); }
        else if (kk == 2 || kk == 3) { ssm_phase(F, a, l, kk - 2); ssm_side_work(F, a, l, kk - 2); }
        else if (k == 3) combine_phase(F, a, l);
        else if (k == 4) { pg8::Gemm g{Yb, (const bf16*)(ws + WS_WGLU) + (size_t)l * 1024 * 1024, M, DSSM, DSSM, DSSM}; pg8::StaticOrder S; S.init(M, DSSM, F.G, F.bx);
            pg8::EpiGLU E{Yb, DSSM, CAT, D}; pg8::gemm_phase<pg8::EpiGLU, pg8::StaticOrder, true, true>(F.lds, g, S, E, F.tid);
            if (l == 0) {
                const bool idle = F.G > 192; if (!idle || F.bx >= 192) { const int iw = (idle ? F.bx - 192 : F.bx) * NWAVES + F.wave, NIW = (idle ? F.G - 192 : F.G) * NWAVES;
                    LAS float* tscr = (LAS float*)(F.lds + F.wave * 16384);
                    for (int it = iw; it < 4000; it += NIW) p0_item(a, tscr, IT_EARLY + it, F.lane); } } }
        else if (k == 7) { pg8::Gemm g{H, (const bf16*)(ws + WS_WGU) + (size_t)l * 11264 * 2048, M, 2 * DFF, D, D}; pg8::StaticOrder S; S.init(M, 2 * DFF, F.G, F.bx);
            pg8::EpiSwiGLU E{(bf16*)(ws + WS_ACT), DFF}; pg8::gemm_phase<pg8::EpiSwiGLU, pg8::StaticOrder, true, true>(F.lds, g, S, E, F.tid); }
        else if (k == 5 || F.G != 256) {
            const bool op = (k == 5), inp = (op && l == 0);
            pg8::Gemm g{op ? CAT : (const bf16*)(ws + WS_ACT), op ? (const bf16*)(ws + WS_WOUT) + (size_t)l * 2048 * 2048 : (const bf16*)(ws + WS_WDN) + (size_t)l * 2048 * 5632, M, D, op ? D : DFF, op ? D : DFF};
            pg8::StaticOrder S; S.init(M, D, F.G, F.bx);
            pg8::EpiResid E{inp ? a->in[0] : X, inp ? a->in[1] - (size_t)MCTX * D : X, modl + (op ? 2 : 5) * D, X, nullptr, 0, 0};
            pg8::gemm_phase<pg8::EpiResid, pg8::StaticOrder, true, true>(F.lds, g, S, E, F.tid);
            if (op && l == 0) {
                const int nbusy = 384 - F.G;
                const bool tail = nbusy > 0 && nbusy < F.G;
                if (!tail || F.bx >= nbusy) { const int iw = (tail ? F.bx - nbusy : F.bx) * NWAVES + F.wave, NIW = (tail ? F.G - nbusy : F.G) * NWAVES;
                    LAS float* tscr = (LAS float*)(F.lds + F.wave * 16384);
                    for (int it = iw; it < IT_LAYER; it += NIW) p0_item(a, tscr, IT_LAYER + it, F.lane); } } }
        else {
            pg8::Gemm g{(const bf16*)(ws + WS_ACT), (const bf16*)(ws + WS_WDN) + (size_t)l * 2048 * 5632, M, D, DFF / 2, DFF};
            pg8::SplitOrder S{F.bx};
            pg8::EpiResid E{X, X, modl + 5 * D, X, (float*)(ws + WS_P), 8192, 4096};
            pg8::gemm_phase<pg8::EpiResid, pg8::SplitOrder, true, true>(F.lds, g, S, E, F.tid); }
        if (ph + 1 < hi) { XcdBarrier bar; bar.bar = (unsigned*)(ws + WS_CTL); bar.x = xb_xcc_id(); bar.st = F.MISC + 8; xcd_barrier(bar); }
    }
}

extern "C" void kernel_launch(void* const* d_in, const int* in_sizes, int n_in, void* d_out, int out_size, void* d_ws, size_t ws_size, hipStream_t stream) {
    static int grid = 0;
    if (grid == 0) {
        if (n_in != 26 || ws_size < WS_END) { fprintf(stderr, "kernel_launch: unexpected n_in %d / ws %zu\n", n_in, ws_size); grid = -1; return; }
        int dev = 0, cus = 0, per_cu = 0;
        if (hipGetDevice(&dev) != hipSuccess || hipDeviceGetAttribute(&cus, hipDeviceAttributeMultiprocessorCount, dev) != hipSuccess) { grid = -1; return; }
        if (hipFuncSetAttribute((const void*)fwd_megakernel, hipFuncAttributeMaxDynamicSharedMemorySize, LDS_BYTES) != hipSuccess) { fprintf(stderr, "kernel_launch: hipFuncSetAttribute failed\n"); grid = -1; return; }
        if (hipOccupancyMaxActiveBlocksPerMultiprocessor(&per_cu, (const void*)fwd_megakernel, NWAVES * 64, LDS_BYTES) != hipSuccess || per_cu < 1) { fprintf(stderr, "kernel_launch: occupancy query says %d\n", per_cu); per_cu = 1; }
        (void)hipGetLastError();
        grid = cus;
    }
    if (grid < 0) return;
    Args a{};
    for (int i = 0; i < 26; ++i) a.in[i] = (const float*)d_in[i];
    a.out = (float*)d_out; a.ws = (unsigned char*)d_ws;
#if MK_ONE_LAUNCH
    (void)hipMemsetAsync((char*)d_ws + WS_CTL, 0, CTL_ZERO_BYTES, stream);
    a.ph_lo = 0; a.ph_hi = NPH;
    void* kargs[] = {&a};
    hipError_t e = hipLaunchCooperativeKernel((const void*)fwd_megakernel, dim3(grid), dim3(NWAVES * 64), kargs, LDS_BYTES, stream);
    if (e != hipSuccess) fprintf(stderr, "cooperative launch failed: %s (grid %d)\n", hipGetErrorString(e), grid);
#else
    for (int p = 0; p < NPH; ++p) { a.ph_lo = p; a.ph_hi = p + 1; hipLaunchKernelGGL(fwd_megakernel, dim3(grid), dim3(NWAVES * 64), LDS_BYTES, stream, a); }
#endif
}
```

```cpp
#include <hip/hip_runtime.h>
#include <hip/hip_cooperative_groups.h>
#include <cstdio>
#include <cstdint>
namespace pg8 {
#define PG8_LAS __attribute__((address_space(3)))
typedef unsigned short bf16_t;
typedef short bf16x8 __attribute__((ext_vector_type(8)));
typedef float f32x4 __attribute__((ext_vector_type(4)));
typedef unsigned u32x4 __attribute__((ext_vector_type(4)));
constexpr int BM = 256, BK = 64, HALF = 128, HTB = HALF * BK * 2  , STAGE_BYTES = 8 * HTB, NXCD = 8, WGM = 6;

__host__ __device__ __forceinline__ int lds_byte(int r, int c) { const int st = (r >> 4) * 2 + (c >> 5), rr = r & 15, cc = c & 31, ob = rr * 64 + cc * 2; return st * 1024 + (ob ^ (((ob >> 9) & 1) << 5)); }
__host__ __device__ __forceinline__ void stage_rc(int b, int& R, int& C) { const int st = b / 1024, sb = b % 1024, swz = sb ^ (((sb >> 9) & 1) << 5); R = (st >> 1) * 16 + swz / 64; C = (st & 1) * 32 + (swz % 64) / 2; }
__host__ __device__ __forceinline__ int perm32(int rho) { const int n = rho >> 4, i = rho & 15; return 8 * (i >> 2) + 4 * n + (i & 3); }

struct Unit { int pm, pn, kh, flags; };
struct Gemm { const bf16_t* A; const bf16_t* Bt; int M, N, K, ld; };

struct StaticOrder {
    int nM, nN, nwg, G, c;
    __host__ __device__ void init(int M, int N, int G_, int c_) { nM = M / BM; nN = N / BM; nwg = nM * nN; G = G_; c = c_; }
    __host__ __device__ bool next(int i, Unit& u) const {
        const long L = (long)i * G + c; if (L >= nwg) return false;
        int wgid = (int)L; { const int q = nwg / NXCD, r = nwg % NXCD, xcd = wgid % NXCD, off = wgid / NXCD; wgid = (xcd < r ? xcd * (q + 1) : r * (q + 1) + (xcd - r) * q) + off; }
        const int nig = WGM * nN, gid = wgid / nig, fm = gid * WGM, gsz = (nM - fm) < WGM ? (nM - fm) : WGM;
        u.pm = fm + ((wgid % nig) % gsz); u.pn = (wgid % nig) / gsz; u.kh = 0; u.flags = 0; return true;
    }
    __device__ __forceinline__ void a_ready(const Unit&) const {}
    __device__ __forceinline__ void done(const Unit&) const {}
};
typedef float f32x2cv __attribute__((ext_vector_type(2))); typedef __bf16 bf16x2cv __attribute__((ext_vector_type(2)));
__device__ __forceinline__ unsigned cvt_pk_bf16(float lo, float hi) { const f32x2cv v = {lo, hi}; const bf16x2cv b = __builtin_convertvector(v, bf16x2cv); return __builtin_bit_cast(unsigned, b); }
typedef float f32x2 __attribute__((ext_vector_type(2)));
typedef float f32x2 __attribute__((ext_vector_type(2)));
__device__ __forceinline__ float bf_lo(unsigned w) { return __uint_as_float(w << 16); }
__device__ __forceinline__ float bf_hi(unsigned w) { return __uint_as_float(w & 0xffff0000u); }
__device__ __forceinline__ float sigmoid_f(float g) { return __builtin_amdgcn_rcpf(1.0f + __expf(-g)); }

struct EpiStoreBf16 {
    static constexpr bool PERM = true, AFTER_DRAIN = false;
    bf16_t* O; int ldc;
    __device__ __forceinline__ void operator()(const f32x4 (&acc)[2][2][4][2], const Unit& u, int wr, int wc, int fr, int fq) const {
        const int row0 = u.pm * BM + wr * 64 + fr, col0 = u.pn * BM + wc * 32 + 8 * fq;
#pragma unroll
        for (int ai = 0; ai < 2; ++ai)
#pragma unroll
            for (int m = 0; m < 4; ++m) { bf16_t* rowp = O + (size_t)(row0 + ai * HALF + m * 16) * ldc + col0;
#pragma unroll
                for (int bj = 0; bj < 2; ++bj) { const f32x4 v0 = acc[ai][bj][m][0], v1 = acc[ai][bj][m][1];
                    u32x4 w; w.x = cvt_pk_bf16(v0[0], v0[1]); w.y = cvt_pk_bf16(v0[2], v0[3]); w.z = cvt_pk_bf16(v1[0], v1[1]); w.w = cvt_pk_bf16(v1[2], v1[3]);
                    *(u32x4*)(rowp + bj * HALF) = w; } }
    }
};
struct EpiGLU {
    static constexpr bool PERM = true, AFTER_DRAIN = false;
    const bf16_t* Y; int ldy; bf16_t* O; int ldc;
    __device__ __forceinline__ void operator()(const f32x4 (&acc)[2][2][4][2], const Unit& u, int wr, int wc, int fr, int fq) const {
        const int row0 = u.pm * BM + wr * 64 + fr, col0 = u.pn * BM + wc * 32 + 8 * fq;
#pragma unroll
        for (int ai = 0; ai < 2; ++ai)
#pragma unroll
            for (int m = 0; m < 4; ++m) { const size_t r = (size_t)(row0 + ai * HALF + m * 16);
#pragma unroll
                for (int bj = 0; bj < 2; ++bj) { const f32x4 v0 = acc[ai][bj][m][0], v1 = acc[ai][bj][m][1];
                    const u32x4 y = *(const u32x4*)(Y + r * ldy + col0 + bj * HALF);
                    u32x4 w;
                    w.x = cvt_pk_bf16(bf_lo(y.x) * sigmoid_f(v0[0]), bf_hi(y.x) * sigmoid_f(v0[1]));
                    w.y = cvt_pk_bf16(bf_lo(y.y) * sigmoid_f(v0[2]), bf_hi(y.y) * sigmoid_f(v0[3]));
                    w.z = cvt_pk_bf16(bf_lo(y.z) * sigmoid_f(v1[0]), bf_hi(y.z) * sigmoid_f(v1[1]));
                    w.w = cvt_pk_bf16(bf_lo(y.w) * sigmoid_f(v1[2]), bf_hi(y.w) * sigmoid_f(v1[3]));
                    *(u32x4*)(O + r * ldc + col0 + bj * HALF) = w; } }
    }
};
struct EpiResid {
    static constexpr bool PERM = true, AFTER_DRAIN = false;
    const float* xlo; const float* xhi;
    const float* gate;
    float* X; float* P; int prow0, prows;
    __device__ __forceinline__ void operator()(const f32x4 (&acc)[2][2][4][2], const Unit& u, int wr, int wc, int fr, int fq) const {
        const int rt = u.pm * BM;
        const int cond = rt < 4096 ? 0 : 1 + ((rt - 4096) >> 10);
        const float* xin = rt < 4096 ? xlo : xhi;
        const int row0 = rt + wr * 64 + fr, col0 = u.pn * BM + wc * 32 + 8 * fq;
        f32x4 gv[2][2];
#pragma unroll
        for (int bj = 0; bj < 2; ++bj)
#pragma unroll
            for (int n = 0; n < 2; ++n) gv[bj][n] = *(const f32x4*)(gate + (size_t)cond * 12288 + col0 + bj * HALF + 4 * n);
        if (u.flags & 2) {
            bf16_t* Pk = (bf16_t*)P + ((ptrdiff_t)u.kh * prows - prow0) * 2048;
#pragma unroll
            for (int ai = 0; ai < 2; ++ai)
#pragma unroll
                for (int m = 0; m < 4; ++m) { const size_t off = (size_t)(row0 + ai * HALF + m * 16) * 2048 + col0;
#pragma unroll
                    for (int bj = 0; bj < 2; ++bj) { const f32x4 o0 = gv[bj][0] * acc[ai][bj][m][0], o1 = gv[bj][1] * acc[ai][bj][m][1];
                        u32x4 w; w.x = cvt_pk_bf16(o0[0], o0[1]); w.y = cvt_pk_bf16(o0[2], o0[3]); w.z = cvt_pk_bf16(o1[0], o1[1]); w.w = cvt_pk_bf16(o1[2], o1[3]);
                        *(u32x4*)(Pk + off + bj * HALF) = w; } }
            return;
        }
#pragma unroll
        for (int ai = 0; ai < 2; ++ai) {
            f32x4 xv[4][2][2];
#pragma unroll
            for (int m = 0; m < 4; ++m) { const size_t off = (size_t)(row0 + ai * HALF + m * 16) * 2048 + col0;
#pragma unroll
                for (int bj = 0; bj < 2; ++bj)
#pragma unroll
                    for (int n = 0; n < 2; ++n) xv[m][bj][n] = *(const f32x4*)(xin + off + bj * HALF + 4 * n); }
#pragma unroll
            for (int m = 0; m < 4; ++m) { const size_t off = (size_t)(row0 + ai * HALF + m * 16) * 2048 + col0;
#pragma unroll
                for (int bj = 0; bj < 2; ++bj)
#pragma unroll
                    for (int n = 0; n < 2; ++n) *(f32x4*)(X + off + bj * HALF + 4 * n) = xv[m][bj][n] + gv[bj][n] * acc[ai][bj][m][n]; }
        }
    }
};
struct SplitOrder {
    int c;
    __host__ __device__ bool next(int i, Unit& u) const {
        if (i >= 3) return false;
        const int x = c & 7, idx = c >> 3;
        if (i < 2) { u.pm = 4 * x + (idx >> 3); u.pn = idx & 7; u.kh = i; u.flags = (i == 0) ? 1 : 0; }
        else { const int tl = idx >> 1; u.pm = 32 + 2 * x + (tl >> 3); u.pn = tl & 7; u.kh = idx & 1; u.flags = 2; }
        return true;
    }
    __device__ __forceinline__ void a_ready(const Unit&) const {}
    __device__ __forceinline__ void done(const Unit&) const {}
};
struct EpiSwiGLU {
    static constexpr bool PERM = true, AFTER_DRAIN = false;
    bf16_t* O; int ldc;
    __device__ __forceinline__ void operator()(const f32x4 (&acc)[2][2][4][2], const Unit& u, int wr, int wc, int fr, int fq) const {
        const int row0 = u.pm * BM + wr * 64 + fr, col0 = u.pn * HALF + wc * 32 + 8 * fq;
#pragma unroll
        for (int ai = 0; ai < 2; ++ai)
#pragma unroll
            for (int m = 0; m < 4; ++m) { const f32x4 g0 = acc[ai][0][m][0], g1 = acc[ai][0][m][1], u0 = acc[ai][1][m][0], u1 = acc[ai][1][m][1];
                u32x4 w;
                w.x = cvt_pk_bf16(g0[0] * sigmoid_f(g0[0]) * u0[0], g0[1] * sigmoid_f(g0[1]) * u0[1]);
                w.y = cvt_pk_bf16(g0[2] * sigmoid_f(g0[2]) * u0[2], g0[3] * sigmoid_f(g0[3]) * u0[3]);
                w.z = cvt_pk_bf16(g1[0] * sigmoid_f(g1[0]) * u1[0], g1[1] * sigmoid_f(g1[1]) * u1[1]);
                w.w = cvt_pk_bf16(g1[2] * sigmoid_f(g1[2]) * u1[2], g1[3] * sigmoid_f(g1[3]) * u1[3]);
                *(u32x4*)(O + (size_t)(row0 + ai * HALF + m * 16) * ldc + col0) = w; }
    }
};

template <class Epi, class Sched, bool ALIGN_EPI = false, bool SP2 = false>
__device__ __forceinline__ void gemm_phase(PG8_LAS unsigned char* lds, const Gemm g, const Sched& S, const Epi& E, const int tid_in) {
    const int tid = tid_in, wid = __builtin_amdgcn_readfirstlane(tid >> 6), lane = tid & 63, wr = wid >> 2, wc = wid & 3, fr = lane & 15, fq = lane >> 4;
    const int K = g.K, nt = K / BK;
    unsigned voffA[2], voffB[2];
#pragma unroll
    for (int i = 0; i < 2; ++i) { int R, C; stage_rc(tid * 16 + i * 8192, R, C); const int Rb = Epi::PERM ? ((R & ~31) + perm32(R & 31)) : R;
        voffA[i] = (unsigned)(R * g.ld + C) * 2u; voffB[i] = (unsigned)(Rb * g.ld + C) * 2u; }
    const size_t kstep = (size_t)(BK * 2);
    const size_t hstep = (size_t)HALF * g.ld * 2;
    const size_t tstep = 2 * hstep;
    const unsigned ldsw = (unsigned)wid * 1024u;
    const int aoff = lds_byte(wr * 64 + fr, fq * 8), boff = lds_byte(wc * 32 + fr, fq * 8);
#define PG8_SA(b, h) (((b) * 2 + (h)) * HTB)
#define PG8_SB(b, h) ((4 + (b) * 2 + (h)) * HTB)
#define PG8_STAGE(bufoff, gbase, voff) do { _Pragma("unroll") for (int _i = 0; _i < 2; ++_i) \
        __builtin_amdgcn_global_load_lds((const unsigned*)((const char*)(gbase) + (voff)[_i]), (PG8_LAS unsigned*)(lds + (bufoff) + ldsw + _i * 8192), 16, 0, 0); } while (0)
#define PG8_LDA(dst, b, h) do { _Pragma("unroll") for (int m = 0; m < 4; ++m) _Pragma("unroll") for (int k = 0; k < 2; ++k) dst[m][k] = *(const PG8_LAS bf16x8*)(lds + PG8_SA(b, h) + aoff + m * 2048 + k * 1024); } while (0)
#define PG8_LDB(dst, b, h) do { _Pragma("unroll") for (int n = 0; n < 2; ++n) _Pragma("unroll") for (int k = 0; k < 2; ++k) dst[n][k] = *(const PG8_LAS bf16x8*)(lds + PG8_SB(b, h) + boff + n * 2048 + k * 1024); } while (0)
#define PG8_MMA(ai, bj, At, Bt) do { __builtin_amdgcn_s_setprio(1); _Pragma("unroll") for (int m = 0; m < 4; ++m) _Pragma("unroll") for (int n = 0; n < 2; ++n) _Pragma("unroll") for (int k = 0; k < 2; ++k) \
        acc[ai][bj][m][n] = __builtin_amdgcn_mfma_f32_16x16x32_bf16(Bt[n][k], At[m][k], acc[ai][bj][m][n], 0, 0, 0); __builtin_amdgcn_s_setprio(0); } while (0)
#define PG8_WAIT_V(n) asm volatile("s_waitcnt vmcnt(" #n ")" ::: "memory")
#define PG8_WAIT_L(n) asm volatile("s_waitcnt lgkmcnt(" #n ")" ::: "memory")
#define PG8_BAR __builtin_amdgcn_s_barrier()
#define PG8_SCHED __builtin_amdgcn_sched_barrier(0)
    Unit cur, nxt; int ui = 0;
    if (!S.next(0, cur)) return;
    f32x4 acc[2][2][4][2];
#pragma unroll
    for (int a = 0; a < 2; ++a)
#pragma unroll
        for (int b = 0; b < 2; ++b)
#pragma unroll
            for (int m = 0; m < 4; ++m)
#pragma unroll
                for (int n = 0; n < 2; ++n) acc[a][b][m][n] = (f32x4){0.f, 0.f, 0.f, 0.f};
    bf16x8 At[4][2], B0[2][2], B1[2][2];
    const size_t khstep = (size_t)K * 2;
    const char* cA = (const char*)g.A + (size_t)cur.pm * tstep + (size_t)cur.kh * khstep; const char* cB = (const char*)g.Bt + (size_t)cur.pn * tstep + (size_t)cur.kh * khstep;
    S.a_ready(cur);
    if constexpr (SP2) {
        PG8_STAGE(PG8_SB(0, 0), cB, voffB); PG8_STAGE(PG8_SB(0, 1), cB + hstep, voffB); PG8_STAGE(PG8_SA(0, 0), cA, voffA); PG8_STAGE(PG8_SA(0, 1), cA + hstep, voffA);
        if (wr == 1) PG8_BAR;
        PG8_WAIT_V(2); PG8_BAR;
        PG8_STAGE(PG8_SB(1, 0), cB + kstep, voffB); PG8_STAGE(PG8_SA(1, 0), cA + kstep, voffA); PG8_STAGE(PG8_SB(1, 1), cB + hstep + kstep, voffB);
        PG8_WAIT_V(6); PG8_BAR;
    } else {
        PG8_STAGE(PG8_SB(0, 0), cB, voffB); PG8_STAGE(PG8_SA(0, 0), cA, voffA); PG8_STAGE(PG8_SB(0, 1), cB + hstep, voffB); PG8_STAGE(PG8_SA(0, 1), cA + hstep, voffA);
        if (wr == 1) PG8_BAR;
        PG8_WAIT_V(4); PG8_BAR;
        PG8_STAGE(PG8_SB(1, 0), cB + kstep, voffB); PG8_STAGE(PG8_SA(1, 0), cA + kstep, voffA); PG8_STAGE(PG8_SB(1, 1), cB + hstep + kstep, voffB);
        PG8_WAIT_V(6); PG8_BAR;
    }
    for (;;) {
        const bool has_next = S.next(ui + 1, nxt);
        const char* nA = has_next ? (const char*)g.A + (size_t)nxt.pm * tstep + (size_t)nxt.kh * khstep : cA; const char* nB = has_next ? (const char*)g.Bt + (size_t)nxt.pn * tstep + (size_t)nxt.kh * khstep : cB;
        for (int t = 0; t < nt; t += 2) {
            const bool last = (t == nt - 2);
            const char* a1 = cA + (size_t)(t + 1) * kstep;
            const char* a2 = last ? nA : cA + (size_t)(t + 2) * kstep; const char* b2 = last ? nB : cB + (size_t)(t + 2) * kstep;
            const char* a3 = a2 + kstep; const char* b3 = b2 + kstep;
            if (last && has_next) S.a_ready(nxt);
            if constexpr (SP2) {
            PG8_LDB(B0, 0, 0); PG8_LDB(B1, 0, 1); PG8_SCHED; PG8_LDA(At, 0, 0); PG8_STAGE(PG8_SA(1, 1), a1 + hstep, voffA);
            PG8_WAIT_V(8); PG8_WAIT_L(0); PG8_BAR; PG8_MMA(0, 0, At, B0); PG8_MMA(0, 1, At, B1); PG8_BAR; PG8_SCHED;
            PG8_LDA(At, 0, 1); PG8_STAGE(PG8_SB(0, 0), b2, voffB); PG8_STAGE(PG8_SB(0, 1), b2 + hstep, voffB); PG8_STAGE(PG8_SA(0, 0), a2, voffA);
            PG8_WAIT_V(8); PG8_WAIT_L(0); PG8_BAR; PG8_MMA(1, 0, At, B0); PG8_MMA(1, 1, At, B1); PG8_BAR; PG8_SCHED;
            PG8_LDB(B0, 1, 0); PG8_LDB(B1, 1, 1); PG8_SCHED; PG8_LDA(At, 1, 0); PG8_STAGE(PG8_SA(0, 1), a2 + hstep, voffA);
            PG8_WAIT_V(8); PG8_WAIT_L(0); PG8_BAR; PG8_MMA(0, 0, At, B0); PG8_MMA(0, 1, At, B1); PG8_BAR; PG8_SCHED;
            PG8_LDA(At, 1, 1); PG8_STAGE(PG8_SB(1, 0), b3, voffB); PG8_STAGE(PG8_SB(1, 1), b3 + hstep, voffB); PG8_STAGE(PG8_SA(1, 0), a3, voffA);
            PG8_WAIT_V(8); PG8_WAIT_L(0); PG8_BAR; PG8_MMA(1, 0, At, B0); PG8_MMA(1, 1, At, B1); PG8_BAR; PG8_SCHED;
            } else {
            PG8_LDB(B0, 0, 0); PG8_SCHED; PG8_LDA(At, 0, 0); PG8_STAGE(PG8_SA(1, 1), a1 + hstep, voffA);
            PG8_WAIT_L(8); PG8_BAR; PG8_WAIT_L(0); PG8_MMA(0, 0, At, B0); PG8_BAR; PG8_SCHED;
            PG8_LDB(B1, 0, 1); PG8_STAGE(PG8_SB(0, 0), b2, voffB);
            PG8_BAR; PG8_WAIT_L(0); PG8_MMA(0, 1, At, B1); PG8_BAR;
            PG8_LDA(At, 0, 1); PG8_STAGE(PG8_SA(0, 0), a2, voffA);
            PG8_BAR; PG8_WAIT_L(0); PG8_MMA(1, 0, At, B0); PG8_BAR; PG8_SCHED;
            PG8_STAGE(PG8_SB(0, 1), b2 + hstep, voffB);
            PG8_WAIT_V(6); PG8_BAR; PG8_MMA(1, 1, At, B1); PG8_BAR;
            PG8_LDB(B0, 1, 0); PG8_SCHED; PG8_LDA(At, 1, 0); PG8_STAGE(PG8_SA(0, 1), a2 + hstep, voffA);
            PG8_WAIT_L(8); PG8_BAR; PG8_WAIT_L(0); PG8_MMA(0, 0, At, B0); PG8_BAR; PG8_SCHED;
            PG8_LDB(B1, 1, 1); PG8_STAGE(PG8_SB(1, 0), b3, voffB);
            PG8_BAR; PG8_WAIT_L(0); PG8_MMA(0, 1, At, B1); PG8_BAR;
            PG8_LDA(At, 1, 1); PG8_STAGE(PG8_SA(1, 0), a3, voffA);
            PG8_BAR; PG8_WAIT_L(0); PG8_MMA(1, 0, At, B0); PG8_BAR; PG8_SCHED;
            PG8_STAGE(PG8_SB(1, 1), b3 + hstep, voffB);
            PG8_WAIT_V(6); PG8_BAR; PG8_MMA(1, 1, At, B1); PG8_BAR;
            }
        }
        if constexpr (ALIGN_EPI) { if (wr == 0) PG8_BAR; }
        const bool keep = (cur.flags & 1) != 0;
        if constexpr (!Epi::AFTER_DRAIN) { if (!keep) { E(acc, cur, wr, wc, fr, fq); S.done(cur); } }
        if (!has_next) break;
        if (!keep) {
#pragma unroll
        for (int a = 0; a < 2; ++a)
#pragma unroll
            for (int b = 0; b < 2; ++b)
#pragma unroll
                for (int m = 0; m < 4; ++m)
#pragma unroll
                    for (int n = 0; n < 2; ++n) acc[a][b][m][n] = (f32x4){0.f, 0.f, 0.f, 0.f};
        }
        cur = nxt; cA = nA; cB = nB; ++ui;
        if constexpr (ALIGN_EPI) { if (wr == 1) PG8_BAR; }
    }
    PG8_WAIT_V(0);
    if constexpr (!ALIGN_EPI) { if (wr == 0) PG8_BAR; }
    PG8_BAR;
    if constexpr (Epi::AFTER_DRAIN) { E.fused(acc, cur, wr, wc, fr, fq, lds, wid, lane); S.done(cur); }
#undef PG8_SA
#undef PG8_SB
#undef PG8_STAGE
#undef PG8_LDA
#undef PG8_LDB
#undef PG8_MMA
#undef PG8_WAIT_V
#undef PG8_WAIT_L
#undef PG8_BAR
#undef PG8_SCHED
}
}

#ifndef MK_ONE_LAUNCH
#define MK_ONE_LAUNCH 1
#endif
constexpr int NWAVES = 8;
constexpr int D = 2048, MCTX = 4096, M = 12288, DIN = 4096, DSSM = 1024, DFF = 5632, NMODC = 12288;
constexpr float EPS = 1e-6f;
constexpr size_t MiB = 1u << 20;
constexpr size_t WS_CTL = 0, CTL_ZERO_BYTES = 64 * 1024;
constexpr size_t WS_MODP = 1 * MiB, WS_MOD = 9 * MiB, WS_TAB = 10 * MiB, WS_E = 11 * MiB;
constexpr size_t WS_WIN = 16 * MiB, WS_WGLU = 48 * MiB, WS_WOUT = 52 * MiB, WS_WGU = 68 * MiB, WS_WDN = 156 * MiB;
constexpr size_t WS_X = 200 * MiB, WS_H = 296 * MiB, WS_CAT = 344 * MiB, WS_Y = 392 * MiB, WS_Z = 416 * MiB, WS_YP = 512 * MiB, WS_ACT = 416 * MiB, WS_P = 548 * MiB, WS_END = 612 * MiB;
constexpr int OUT_STATE = 12288 * 2048;
constexpr int RING_BYTES = 131072, LDSCTL_OFF = RING_BYTES, MISC_OFF = LDSCTL_OFF + 320, LDS_BYTES = 147456;

#define GAS __attribute__((address_space(1)))
#define LAS __attribute__((address_space(3)))
typedef unsigned short bf16;
typedef unsigned v4u __attribute__((ext_vector_type(4)));
typedef unsigned v2u __attribute__((ext_vector_type(2)));
typedef float f32x4 __attribute__((ext_vector_type(4)));
typedef float f32x16 __attribute__((ext_vector_type(16)));
typedef short bf16x8 __attribute__((ext_vector_type(8)));
#define LDS_WAIT() asm volatile("s_waitcnt lgkmcnt(0)" ::: "memory")
#define VM_WAIT() asm volatile("s_waitcnt vmcnt(0)" ::: "memory")
__device__ __forceinline__ unsigned pk2(float lo, float hi) { return pg8::cvt_pk_bf16(lo, hi); }
__device__ __forceinline__ float blo(unsigned w) { return __uint_as_float(w << 16); }
__device__ __forceinline__ float bhi(unsigned w) { return __uint_as_float(w & 0xffff0000u); }

#define XB_TMO      128
#define XB_XCNT(j)  (256  + 64 * (j))
#define XB_XSUB(j)  (1280 + 64 * (j))
#define XB_XGEN(j)  (2304 + 64 * (j))
#define XB_TOP      3328
#define XB_TOPGEN   3392
#define XCD_BAR_WORDS 3456
#define XB_SPIN_CAP (1u << 18)

__device__ __forceinline__ unsigned xb_ld(unsigned* p)              { return __hip_atomic_load(p, __ATOMIC_RELAXED, __HIP_MEMORY_SCOPE_AGENT); }
__device__ __forceinline__ unsigned xb_add(unsigned* p, unsigned v) { return __hip_atomic_fetch_add(p, v, __ATOMIC_RELAXED, __HIP_MEMORY_SCOPE_AGENT); }
__device__ __forceinline__ unsigned xb_xcc_id() { return (unsigned)__builtin_amdgcn_s_getreg((3 << 11) | 20) & 0xFu; }
#define XB_SPIN(cond, bar) do { unsigned _sp = 0; while (cond) { __builtin_amdgcn_s_sleep(1); \
    if ((++_sp & 255u) == 0u) { if (xb_ld(&(bar)[XB_TMO])) break; if (_sp > XB_SPIN_CAP) { atomicAdd(&(bar)[XB_TMO], 1u); break; } } } } while (0)

struct XcdBarrier {
    unsigned* bar; unsigned x;
    volatile LAS unsigned* st;
};

__device__ __forceinline__ XcdBarrier xcd_barrier_post(unsigned* bar, volatile LAS unsigned* st) {
    XcdBarrier b; b.bar = bar; b.x = xb_xcc_id(); b.st = st;
    if (threadIdx.x == 0) (void)xb_add(&bar[XB_XCNT(b.x)], 1u);
    return b;
}
__device__ __forceinline__ void xcd_barrier_complete(unsigned* bar, unsigned x, unsigned& nloc, unsigned& nx) {
    const unsigned G = gridDim.x * gridDim.y * gridDim.z;
    unsigned sum, cnt, mine, sp = 0u;
    for (;;) {
        sum = 0u; cnt = 0u; mine = 0u;
#pragma unroll
        for (unsigned j = 0; j < 16; ++j) { const unsigned c = xb_ld(&bar[XB_XCNT(j)]); sum += c; cnt += (c > 0u) ? 1u : 0u; mine = (j == x) ? c : mine; }
        if (sum == G) break;
        __builtin_amdgcn_s_sleep(1);
        if ((++sp & 255u) == 0u) { if (xb_ld(&bar[XB_TMO])) break; if (sp > XB_SPIN_CAP) { atomicAdd(&bar[XB_TMO], 1u); break; } }
    }
    nloc = mine > 0u ? mine : 1u; nx = cnt > 0u ? cnt : 1u;
}

__device__ __forceinline__ void xcd_barrier(const XcdBarrier& b) {
    asm volatile("s_waitcnt vmcnt(0)" ::: "memory");
    __syncthreads();
    if (threadIdx.x == 0) {
        unsigned* bar = b.bar;
        __builtin_amdgcn_s_waitcnt(0);
        unsigned nloc = b.st[0], nx = b.st[1];
        if (nloc == 0u) { xcd_barrier_complete(bar, b.x, nloc, nx); b.st[0] = nloc; b.st[1] = nx; }
        const unsigned old = xb_add(&bar[XB_XSUB(b.x)], 1u);
        const unsigned gen = old / nloc;
        if (old + 1u == (gen + 1u) * nloc) {
            __builtin_amdgcn_fence(__ATOMIC_RELEASE, "agent");
            asm volatile("s_waitcnt vmcnt(0)" ::: "memory");
            const unsigned og = xb_add(&bar[XB_TOP], 1u);
            const unsigned tg = og / nx;
            if (og + 1u == (tg + 1u) * nx) xb_add(&bar[XB_TOPGEN], 1u);
            else XB_SPIN(xb_ld(&bar[XB_TOPGEN]) == tg, bar);
            __builtin_amdgcn_fence(__ATOMIC_ACQUIRE, "agent");
            xb_add(&bar[XB_XGEN(b.x)], 1u);
            asm volatile("s_waitcnt vmcnt(0)" ::: "memory");
        } else {
            XB_SPIN(xb_ld(&bar[XB_XGEN(b.x)]) == gen, bar);
            __builtin_amdgcn_fence(__ATOMIC_ACQUIRE, "agent");
            asm volatile("s_waitcnt vmcnt(0)" ::: "memory");
        }
    }
    __syncthreads();
}

struct Frame {
    LAS unsigned char* lds;
    volatile LAS unsigned* MISC;
    int tid, lane, wave, G, bx;
};
struct Args { const float* in[26]; float* out; unsigned char* ws; int ph_lo, ph_hi; };
typedef const Args __attribute__((address_space(4)))* KArgs;
__device__ __forceinline__ KArgs get_args() { KArgs p = (KArgs)__builtin_amdgcn_kernarg_segment_ptr(); asm volatile("" : "+s"(p)); return p; }

__device__ __forceinline__ float wave_sum(float v, int lane) {
#pragma unroll
    for (int o = 1; o < 64; o <<= 1) v += __int_as_float(__builtin_amdgcn_ds_bpermute((lane ^ o) << 2, __float_as_int(v)));
    return v;
}

__device__ __forceinline__ void p0_transpose_item(const float* W, int K, int N, bf16* WT, int drow0, LAS float* scr, int k0, int n0, int lane) {
    float wv[32];
#pragma unroll
    for (int i = 0; i < 32; ++i) wv[i] = __builtin_nontemporal_load(W + (size_t)(k0 + 2 * i + (lane >> 5)) * N + n0 + (lane & 31));
#pragma unroll
    for (int i = 0; i < 32; ++i) scr[(2 * i + (lane >> 5)) * 33 + (lane & 31)] = wv[i];
    LDS_WAIT(); asm volatile("" ::: "memory");
    const int c = lane & 7;
#pragma unroll
    for (int j = 0; j < 4; ++j) { const int n = (lane >> 3) + 8 * j; const LAS float* s = scr + (8 * c) * 33 + n;
        v4u o; o.x = pk2(s[0 * 33], s[1 * 33]); o.y = pk2(s[2 * 33], s[3 * 33]); o.z = pk2(s[4 * 33], s[5 * 33]); o.w = pk2(s[6 * 33], s[7 * 33]);
        *(GAS v4u*)(WT + (size_t)(drow0 + n) * K + k0 + 8 * c) = o; }
    LDS_WAIT(); asm volatile("" ::: "memory");
}
constexpr int IT_IN = 32 * 128, IT_GLU = 16 * 32, IT_OUT = 32 * 64, IT_G = 32 * 176, IT_DN = 88 * 64;
constexpr int IT_LAYER = IT_IN + IT_GLU + IT_OUT + 2 * IT_G + IT_DN;
constexpr int IT_TOTAL = 2 * IT_LAYER;
constexpr int IT_EARLY = IT_IN + IT_GLU + IT_OUT;
__device__ __forceinline__ void p0_item(KArgs a, LAS float* scr, int it, int lane) {
    const int l = it / IT_LAYER; int r = it - l * IT_LAYER;
    unsigned char* ws = a->ws;
    if (r < IT_IN) { const int kb = r / 128, nb = r % 128;
        p0_transpose_item(a->in[8] + (size_t)l * 2048 * 4096, 2048, 4096, (bf16*)(ws + WS_WIN) + (size_t)l * 4096 * 2048, 32 * nb, scr, 64 * kb, 32 * nb, lane); return; } r -= IT_IN;
    if (r < IT_GLU) { const int kb = r / 32, nb = r % 32;
        p0_transpose_item(a->in[17] + (size_t)l * 1024 * 1024, 1024, 1024, (bf16*)(ws + WS_WGLU) + (size_t)l * 1024 * 1024, 32 * nb, scr, 64 * kb, 32 * nb, lane); return; } r -= IT_GLU;
    if (r < IT_OUT) { const int kb = r / 64, nb = r % 64;
        p0_transpose_item(a->in[20] + (size_t)l * 2048 * 2048, 2048, 2048, (bf16*)(ws + WS_WOUT) + (size_t)l * 2048 * 2048, 32 * nb, scr, 64 * kb, 32 * nb, lane); return; } r -= IT_OUT;
    if (r < 2 * IT_G) { const int up = r >= IT_G; if (up) r -= IT_G; const int kb = r / 176, nb = r % 176, n0 = 32 * nb;
        p0_transpose_item(a->in[up ? 23 : 22] + (size_t)l * 2048 * 5632, 2048, 5632, (bf16*)(ws + WS_WGU) + (size_t)l * 11264 * 2048, (n0 >> 7) * 256 + (n0 & 127) + (up ? 128 : 0), scr, 64 * kb, n0, lane); return; } r -= 2 * IT_G;
    { const int kb = r / 64, nb = r % 64;
        p0_transpose_item(a->in[24] + (size_t)l * 5632 * 2048, 5632, 2048, (bf16*)(ws + WS_WDN) + (size_t)l * 2048 * 5632, 32 * nb, scr, 64 * kb, 32 * nb, lane); }
}
constexpr int MOD_TASKS = 2 * 96 * 8;
__device__ __forceinline__ void p0_mod_task(KArgs a, LAS float* scr, int task, int lane) {
    const int ks = task & 7, cgp = (task >> 3) % 96, l = task / 768;
    const int kb = ks * 256;
    const float* cin = a->in[3]; const float* cctx = a->in[4];
#pragma unroll
    for (int i = 0; i < 4; ++i) { const int kk = lane + 64 * i;
#pragma unroll
        for (int c = 0; c < 9; ++c) { const float v = c == 0 ? cctx[kb + kk] : cin[(c - 1) * 2048 + kb + kk]; scr[c * 256 + kk] = v * __builtin_amdgcn_rcpf(1.0f + __expf(-v)); } }
    LDS_WAIT(); asm volatile("" ::: "memory");
    const float* w = a->in[5] + ((size_t)l * 2048 + kb) * NMODC + cgp * 128 + 2 * lane;
    pg8::f32x2 acc[9];
#pragma unroll
    for (int c = 0; c < 9; ++c) acc[c] = (pg8::f32x2){0.f, 0.f};
    for (int kk = 0; kk < 256; kk += 8) {
        pg8::f32x2 wv[8];
#pragma unroll
        for (int j = 0; j < 8; ++j) wv[j] = __builtin_nontemporal_load((const pg8::f32x2*)(w + (size_t)(kk + j) * NMODC));
#pragma unroll
        for (int j = 0; j < 8; ++j)
#pragma unroll
            for (int c = 0; c < 9; ++c) acc[c] += scr[c * 256 + kk + j] * wv[j];
    }
    LDS_WAIT(); asm volatile("" ::: "memory");
#pragma unroll
    for (int c = 0; c < 9; ++c) *(LAS pg8::f32x2*)((LAS unsigned char*)scr + c * 512 + lane * 8) = acc[c];
}
__device__ __forceinline__ void p0_mod_finish(KArgs a, LAS unsigned char* lds0, int task, int wave, int lane) {
    const int cgp = (task >> 3) % 96, l = task / 768;
    for (int c = wave; c < 9; c += 8) {
        pg8::f32x2 s = *(const pg8::f32x2*)(a->in[6] + (size_t)l * NMODC + cgp * 128 + 2 * lane);
#pragma unroll
        for (int ks = 0; ks < 8; ++ks) s += *(const LAS pg8::f32x2*)(lds0 + ks * 16384 + c * 512 + lane * 8);
        *(pg8::f32x2*)((float*)(a->ws + WS_MOD) + ((size_t)l * 9 + c) * NMODC + cgp * 128 + 2 * lane) = s;
    }
}
__device__ __forceinline__ void sincos_f(float x, float& s, float& c) {
    const float q = rintf(x * 0.636619772367581343f);
    float r = fmaf(-q, 1.57079637050628662109375f, x); r = fmaf(-q, -4.37113900018624283e-8f, r);
    const float r2 = r * r;
    float sp = fmaf(r2, 2.7557319e-6f, -1.9841270e-4f); sp = fmaf(sp, r2, 8.3333333e-3f); sp = fmaf(sp, r2, -1.6666667e-1f); sp = fmaf(sp * r2, r, r);
    float cp = fmaf(r2, -2.7557319e-7f, 2.4801587e-5f); cp = fmaf(cp, r2, -1.3888889e-3f); cp = fmaf(cp, r2, 4.1666667e-2f); cp = fmaf(cp, r2, -0.5f); cp = fmaf(cp, r2, 1.0f);
    const int qi = (int)q & 3;
    s = (qi == 0) ? sp : (qi == 1) ? cp : (qi == 2) ? -sp : -cp;
    c = (qi == 0) ? cp : (qi == 1) ? -sp : (qi == 2) ? -cp : sp;
}
__device__ __forceinline__ void p0_ssm_tab(KArgs a, int idx) {
    const int ldg = idx >> 6;
    const float lre = fminf(a->in[9][idx], -1e-4f), lim = a->in[10][idx];
    const float dt = __expf(a->in[11][ldg]);
    const float x = lre * dt, y = lim * dt;
    float em1;
    if (fabsf(x) < 0.25f) { float t = fmaf(x, 1.0f / 5040.0f, 1.0f / 720.0f); t = fmaf(t, x, 1.0f / 120.0f); t = fmaf(t, x, 1.0f / 24.0f); t = fmaf(t, x, 1.0f / 6.0f); t = fmaf(t, x, 0.5f); t = fmaf(t, x, 1.0f); em1 = t * x; }
    else em1 = __expf(x) - 1.0f;
    const float ex = 1.0f + em1;
    float sy, cy, sh, ch; sincos_f(y, sy, cy); sincos_f(0.5f * y, sh, ch);
    const float are = ex * cy, aim = ex * sy;
    const float nre = fmaf(em1, cy, -2.0f * sh * sh), nim = aim;
    const float den = __builtin_amdgcn_rcpf(lre * lre + lim * lim);
    f32x4 o; o.x = are; o.y = aim; o.z = (nre * lre + nim * lim) * den; o.w = (nim * lre - nre * lim) * den;
    ((f32x4*)(a->ws + WS_TAB))[idx] = o;
}
__device__ __forceinline__ void p0_prologue(Frame& F, KArgs a) {
    LAS float* scr = (LAS float*)(F.lds + F.wave * 16384);
    const int gw = F.bx * NWAVES + F.wave, NGW = F.G * NWAVES;
    const int gt = F.bx * (NWAVES * 64) + F.tid;
    for (int i = gt; i < 16384; i += NGW * 64) p0_ssm_tab(a, i);
    constexpr int NIT = IT_EARLY;
    int nmodw = NGW > MOD_TASKS ? MOD_TASKS : 0;
    if (nmodw == 0) { for (int t = gw; t < MOD_TASKS; t += NGW) { p0_mod_task(a, scr, t, F.lane); LDS_WAIT(); __syncthreads(); p0_mod_finish(a, F.lds, t, F.wave, F.lane); LDS_WAIT(); __syncthreads(); } for (int it = gw; it < NIT; it += NGW) p0_item(a, scr, it, F.lane); return; }
    int share = (NIT + 16 * MOD_TASKS) / NGW - 16; if (share < 0) share = 0;
    const int rest = NIT - share * nmodw, nother = NGW - nmodw, per = (rest + nother - 1) / nother;
    int lo, hi;
    if (gw < nmodw) { p0_mod_task(a, scr, gw, F.lane); LDS_WAIT(); __syncthreads(); p0_mod_finish(a, F.lds, gw, F.wave, F.lane); LDS_WAIT(); __syncthreads(); lo = gw * share; hi = lo + share; }
    else { lo = share * nmodw + (gw - nmodw) * per; hi = lo + per; if (hi > NIT) hi = NIT; }
    for (int it = lo; it < hi; ++it) p0_item(a, scr, it, F.lane);
}
__device__ __forceinline__ void p1_mod_reduce(Frame& F, KArgs a) {
    const int gt = F.bx * (NWAVES * 64) + F.tid, NT = F.G * NWAVES * 64;
    const f32x4* P = (const f32x4*)(a->ws + WS_MODP); f32x4* O = (f32x4*)(a->ws + WS_MOD);
    constexpr int N4 = 2 * 9 * NMODC / 4, J4 = NMODC / 4;
    for (int i = gt; i < N4; i += NT) { const int l = i / (9 * J4), j4 = i % J4;
        f32x4 s = ((const f32x4*)(a->in[6]))[l * J4 + j4];
#pragma unroll
        for (int ks = 0; ks < 8; ++ks) s += P[(size_t)ks * N4 + i];
        O[i] = s; }
}

__device__ __forceinline__ int cond_of(int row) { return row < MCTX ? 0 : 1 + ((row - MCTX) >> 10); }
__device__ __forceinline__ void norm_mod_phase(Frame& F, const float* xlo, const float* xhi, const float* g, const float* modl, int sh_i, int sc_i, bf16* H, const float* P, float* Xw) {
    const int gw = F.bx * NWAVES + F.wave, NGW = F.G * NWAVES;
    for (int row = gw; row < M; row += NGW) {
        const f32x4* xr = (const f32x4*)((row < MCTX ? xlo : xhi) + (size_t)row * D) + F.lane;
        f32x4 v[8]; float s = 0.f;
        if (P && row >= 8192) {
            const v2u* p0 = (const v2u*)((const bf16*)P + (size_t)(row - 8192) * D) + F.lane; const v2u* p1 = p0 + (size_t)4096 * D / 4;     f32x4* xw = (f32x4*)(Xw + (size_t)row * D) + F.lane;
#pragma unroll
            for (int j = 0; j < 8; ++j) { { const v2u q0 = p0[64 * j], q1 = p1[64 * j]; v[j] = xr[64 * j] + (f32x4){blo(q0.x), bhi(q0.x), blo(q0.y), bhi(q0.y)} + (f32x4){blo(q1.x), bhi(q1.x), blo(q1.y), bhi(q1.y)}; } xw[64 * j] = v[j]; s += (v[j].x * v[j].x + v[j].y * v[j].y) + (v[j].z * v[j].z + v[j].w * v[j].w); }
        } else {
#pragma unroll
        for (int j = 0; j < 8; ++j) { v[j] = xr[64 * j]; s += (v[j].x * v[j].x + v[j].y * v[j].y) + (v[j].z * v[j].z + v[j].w * v[j].w); }
        }
        const float rstd = __builtin_amdgcn_rsqf(wave_sum(s, F.lane) * (1.0f / D) + EPS);
        const float* mc = modl + (size_t)cond_of(row) * NMODC;
        const f32x4* g4 = (const f32x4*)g + F.lane; const f32x4* sc4 = (const f32x4*)(mc + sc_i * D) + F.lane; const f32x4* sh4 = (const f32x4*)(mc + sh_i * D) + F.lane;
        v2u* o = (v2u*)(H + (size_t)row * D) + F.lane;
#pragma unroll
        for (int j = 0; j < 8; ++j) { const f32x4 y = (v[j] * rstd) * g4[64 * j]; const f32x4 h = y * (1.0f + sc4[64 * j]) + sh4[64 * j];
            v2u w; w.x = pk2(h.x, h.y); w.y = pk2(h.z, h.w); o[64 * j] = w; }
    }
}
__device__ __forceinline__ void final_norm_phase(Frame& F, const float* X, const float* g, float* out, const float* P) {
    const int gw = F.bx * NWAVES + F.wave, NGW = F.G * NWAVES;
    for (int row = gw; row < M; row += NGW) {
        const f32x4* xr = (const f32x4*)(X + (size_t)row * D) + F.lane;
        f32x4 v[8]; float s = 0.f;
        if (P && row >= 8192) {
            const v2u* p0 = (const v2u*)((const bf16*)P + (size_t)(row - 8192) * D) + F.lane; const v2u* p1 = p0 + (size_t)4096 * D / 4;
#pragma unroll
            for (int j = 0; j < 8; ++j) { { const v2u q0 = p0[64 * j], q1 = p1[64 * j]; v[j] = xr[64 * j] + (f32x4){blo(q0.x), bhi(q0.x), blo(q0.y), bhi(q0.y)} + (f32x4){blo(q1.x), bhi(q1.x), blo(q1.y), bhi(q1.y)}; } s += (v[j].x * v[j].x + v[j].y * v[j].y) + (v[j].z * v[j].z + v[j].w * v[j].w); }
        } else {
#pragma unroll
        for (int j = 0; j < 8; ++j) { v[j] = xr[64 * j]; s += (v[j].x * v[j].x + v[j].y * v[j].y) + (v[j].z * v[j].z + v[j].w * v[j].w); }
        }
        const float rstd = __builtin_amdgcn_rsqf(wave_sum(s, F.lane) * (1.0f / D) + EPS);
        const f32x4* g4 = (const f32x4*)g + F.lane; f32x4* o = (f32x4*)(out + (size_t)row * D) + F.lane;
#pragma unroll
        for (int j = 0; j < 8; ++j) __builtin_nontemporal_store((v[j] * rstd) * g4[64 * j], o + 64 * j);
    }
}
__device__ __forceinline__ float gelu_tanh(float x) { const float t = 1.5957691216057308f * fmaf(0.044715f * x * x, x, x); return x * __builtin_amdgcn_rcpf(1.0f + __expf(-t)); }
__device__ __forceinline__ void conv_row(KArgs a, int l, int row, int lane) {
    const bf16* Z = (const bf16*)(a->ws + WS_Z); bf16* CAT = (bf16*)(a->ws + WS_CAT);
    const float* cw = a->in[18] + (size_t)l * 3 * 1024; const float* cb = a->in[19] + (size_t)l * 1024;
    const int t = row < MCTX ? (row & 255) : ((row - MCTX) & 63), Lc = row < MCTX ? 256 : 64;
    const bool hp = t > 0, hn = t < Lc - 1;
    const bf16* zr = Z + (size_t)row * DIN;
    v4u gc[2], vv[2], gb[2], gcp[2], vp[2], gcn[2], vn[2];
#pragma unroll
    for (int hc = 0; hc < 2; ++hc) {
        const int c0 = hc * 512 + lane * 8;
        gc[hc] = *(const v4u*)(zr + 2048 + c0); vv[hc] = *(const v4u*)(zr + 3072 + c0); gb[hc] = *(const v4u*)(zr + 1024 + c0);
        gcp[hc] = (v4u){0u, 0u, 0u, 0u}; vp[hc] = gcp[hc]; gcn[hc] = gcp[hc]; vn[hc] = gcp[hc];
        if (hp) { gcp[hc] = *(const v4u*)(zr - DIN + 2048 + c0); vp[hc] = *(const v4u*)(zr - DIN + 3072 + c0); }
        if (hn) { gcn[hc] = *(const v4u*)(zr + DIN + 2048 + c0); vn[hc] = *(const v4u*)(zr + DIN + 3072 + c0); }
    }
#pragma unroll
    for (int hc = 0; hc < 2; ++hc) {
        const int c0 = hc * 512 + lane * 8;
        unsigned ow[4];
#pragma unroll
        for (int q = 0; q < 4; ++q) {
            const int c = c0 + 2 * q;
            const float z0 = blo(gc[hc][q]) * blo(vv[hc][q]), z1 = bhi(gc[hc][q]) * bhi(vv[hc][q]);
            const float p0 = blo(gcp[hc][q]) * blo(vp[hc][q]), p1 = bhi(gcp[hc][q]) * bhi(vp[hc][q]);
            const float n0 = blo(gcn[hc][q]) * blo(vn[hc][q]), n1 = bhi(gcn[hc][q]) * bhi(vn[hc][q]);
            const float r0 = cw[c] * p0 + cw[1024 + c] * z0 + cw[2048 + c] * n0 + cb[c];
            const float r1 = cw[c + 1] * p1 + cw[1024 + c + 1] * z1 + cw[2048 + c + 1] * n1 + cb[c + 1];
            ow[q] = pk2(blo(gb[hc][q]) * r0, bhi(gb[hc][q]) * r1);
        }
        *(v4u*)(CAT + (size_t)row * D + 1024 + c0) = (v4u){ow[0], ow[1], ow[2], ow[3]};
    }
}
__device__ __forceinline__ void combine_row(KArgs a, int l, int row, int lane) {
    const bf16* Z = (const bf16*)(a->ws + WS_Z); bf16* Y = (bf16*)(a->ws + WS_Y); const float* YP = (const float*)(a->ws + WS_YP);
    const float* dsk = a->in[16] + (size_t)l * 1024;
    const bf16* zr = Z + (size_t)row * DIN;
#pragma unroll
    for (int hc = 0; hc < 2; ++hc) {
        const int c0 = hc * 512 + lane * 8;
        const v4u uu = *(const v4u*)(zr + c0);
        const f32x4 a0 = *(const f32x4*)(YP + (size_t)row * 1024 + c0), a1 = *(const f32x4*)(YP + (size_t)row * 1024 + c0 + 4);
        const f32x4 b0 = *(const f32x4*)(YP + (size_t)(M + row) * 1024 + c0), b1 = *(const f32x4*)(YP + (size_t)(M + row) * 1024 + c0 + 4);
        const f32x4 d0 = *(const f32x4*)(dsk + c0), d1 = *(const f32x4*)(dsk + c0 + 4);
        f32x4 y0, y1;
        y0.x = a0.x + b0.x + d0.x * blo(uu.x); y0.y = a0.y + b0.y + d0.y * bhi(uu.x); y0.z = a0.z + b0.z + d0.z * blo(uu.y); y0.w = a0.w + b0.w + d0.w * bhi(uu.y);
        y1.x = a1.x + b1.x + d1.x * blo(uu.z); y1.y = a1.y + b1.y + d1.y * bhi(uu.z); y1.z = a1.z + b1.z + d1.z * blo(uu.w); y1.w = a1.w + b1.w + d1.w * bhi(uu.w);
        v4u yo; yo.x = pk2(gelu_tanh(y0.x), gelu_tanh(y0.y)); yo.y = pk2(gelu_tanh(y0.z), gelu_tanh(y0.w)); yo.z = pk2(gelu_tanh(y1.x), gelu_tanh(y1.y)); yo.w = pk2(gelu_tanh(y1.z), gelu_tanh(y1.w));
        *(v4u*)(Y + (size_t)row * 1024 + c0) = yo;
    }
}
__device__ __forceinline__ void combine_phase(Frame& F, KArgs a, int l) {
    const int gw = F.bx * NWAVES + F.wave, NGW = F.G * NWAVES;
    const int row_lo = NGW > 10 * 128 + 64 ? MCTX : 0;
    for (int row = row_lo + gw; row < M; row += NGW) combine_row(a, l, row, F.lane);
}
constexpr int SIDE_LDS_OFF = 40960;
__device__ __forceinline__ void ssm_side_work(Frame& F, KArgs a, int l, int pass) {
    const int vw = F.wave == 4 ? 7 : F.wave == 7 ? 4 : F.wave;
    const int NGW = F.G * NWAVES, gwi = vw * F.G + F.bx;
    const int ntask = pass == 0 ? 10 * 128 : 6 * 128;
    int sw, NSW;
    if (NGW <= 10 * 128 + 64) { sw = F.bx * NWAVES + F.wave; NSW = NGW; }
    else { if (gwi < ntask) return; sw = gwi - ntask; NSW = NGW - ntask; }
    LAS float* scr = (LAS float*)(F.lds + SIDE_LDS_OFF + F.wave * 8448);
    const int idle0 = NGW > 10 * 128 + 64 ? NGW - 10 * 128 : NGW, idle1 = NGW > 10 * 128 + 64 ? NGW - 6 * 128 : NGW;
    const int R0 = l == 0 ? (M * 3) / 4 : (int)(((long)M * idle0) / (idle0 + idle1));
    constexpr int NG2 = 4000, NI0 = NG2 + 4000, NIS = IT_LAYER - IT_EARLY;
    if (pass == 0) { for (int row = sw; row < R0; row += NSW) conv_row(a, l, row, F.lane);
        if (l == 0) for (int it = NG2 + sw; it < NI0; it += NSW) p0_item(a, scr, IT_EARLY + it, F.lane); }
    else { for (int row = R0 + sw; row < M; row += NSW) conv_row(a, l, row, F.lane);
        if (NGW > 10 * 128 + 64) for (int row = sw; row < MCTX; row += NSW) combine_row(a, l, row, F.lane);
        if (l == 0) for (int it = NI0 + sw; it < NIS; it += NSW) p0_item(a, scr, IT_EARLY + it, F.lane); }
}

constexpr int SSM_ROWB = 272, SSM_SCR = 16 * SSM_ROWB;
constexpr int SSM_TASKS0 = 10 * 128, SSM_TASKS1 = 6 * 128;
__device__ __forceinline__ void ssm_phase(Frame& F, KArgs a, int l, int pass) {
    LAS unsigned char* scr = F.lds + F.wave * SSM_SCR;
    const int lane = F.lane, c = lane & 15, r = lane >> 4;
    const int vw = F.wave == 4 ? 7 : F.wave == 7 ? 4 : F.wave;
    const int gwi = vw * F.G + F.bx, NGW = F.G * NWAVES;
    const bf16* Z = (const bf16*)(a->ws + WS_Z); float* YP = (float*)(a->ws + WS_YP);
    const f32x4* TAB = (const f32x4*)(a->ws + WS_TAB);
    float* EB = (float*)(a->ws + WS_E);
    const int ntask = pass == 0 ? SSM_TASKS0 : SSM_TASKS1;
    __builtin_amdgcn_s_setprio(3);
    for (int task = gwi; task < ntask; task += NGW) {
        const int q = task >> 7, t_ = task & 127, d = t_ & 1, g = t_ >> 1;
        bool lat, local = false; int k = 0, b;
        if (pass == 0) { if (q < 4) { lat = false; b = 4 * q + r; } else if (q < 6) { lat = true; k = 0; b = 4 * (q - 4) + r; } else { lat = true; local = true; k = 1 + ((q - 6) >> 1); b = 4 * ((q - 6) & 1) + r; } }
        else { lat = true; k = 1 + (q >> 1); b = 4 * (q & 1) + r; }
        const int L = lat ? 1024 : 256, P0 = 256 * k;
        const int b0 = b - r;
        const int rowbase0 = lat ? MCTX + b0 * 1024 : b0 * 256;
        const int ldg = (l * 2 + d) * 64 + g;
        float ar[4], ai[4], sr[4], si[4];
        bf16x8 Bop[8], Cm[4];
#pragma unroll
        for (int t = 0; t < 4; ++t) {
            const f32x4 tb = TAB[ldg * 64 + c + 16 * t]; ar[t] = tb.x; ai[t] = tb.y;
            v4u wre = (v4u){0u, 0u, 0u, 0u}, wim = wre;
            if (r < 2) {
                const float* br = a->in[12] + ((size_t)ldg * 64 + c + 16 * t) * 16 + 8 * r; const float* bi = a->in[13] + ((size_t)ldg * 64 + c + 16 * t) * 16 + 8 * r;
                const f32x4 r0 = *(const f32x4*)br, r1 = *(const f32x4*)(br + 4), i0 = *(const f32x4*)bi, i1 = *(const f32x4*)(bi + 4);
                const f32x4 re0 = tb.z * r0 - tb.w * i0, re1 = tb.z * r1 - tb.w * i1, im0 = tb.z * i0 + tb.w * r0, im1 = tb.z * i1 + tb.w * r1;
                wre.x = pk2(re0.x, re0.y); wre.y = pk2(re0.z, re0.w); wre.z = pk2(re1.x, re1.y); wre.w = pk2(re1.z, re1.w);
                wim.x = pk2(im0.x, im0.y); wim.y = pk2(im0.z, im0.w); wim.z = pk2(im1.x, im1.y); wim.w = pk2(im1.z, im1.w);
            }
            Bop[2 * t] = __builtin_bit_cast(bf16x8, wre); Bop[2 * t + 1] = __builtin_bit_cast(bf16x8, wim);
            sr[t] = 0.f; si[t] = 0.f;
            const int p = c + 16 * t;
            if (lat && k == 0) { const float* st = a->in[2] + (size_t)(((b * 2 + l) * 2 + d) * 2) * 4096 + g * 64; sr[t] = st[p]; si[t] = st[4096 + p]; }
            if (pass == 1) {
                float pr = ar[t], pi = ai[t];
#pragma unroll
                for (int e = 0; e < 8; ++e) { const float nr = pr * pr - pi * pi, ni = 2.f * pr * pi; pr = nr; pi = ni; }
                const float* e0 = EB + ((size_t)((b * 3 + 0) * 2 + d) * 64 + g) * 128;
                float cr_ = e0[p], ci_ = e0[64 + p];
                if (k >= 2) { const float* e1 = EB + ((size_t)((b * 3 + 1) * 2 + d) * 64 + g) * 128; const float nr = pr * cr_ - pi * ci_ + e1[p], ni = pr * ci_ + pi * cr_ + e1[64 + p]; cr_ = nr; ci_ = ni; }
                if (k >= 3) { const float* e2 = EB + ((size_t)((b * 3 + 2) * 2 + d) * 64 + g) * 128; const float nr = pr * cr_ - pi * ci_ + e2[p], ni = pr * ci_ + pi * cr_ + e2[64 + p]; cr_ = nr; ci_ = ni; }
                sr[t] = cr_; si[t] = ci_;
            }
        }
#pragma unroll
        for (int ks = 0; ks < 4; ++ks) { const int p = 16 * ks + 4 * r;
            const f32x4 cr = *(const f32x4*)(a->in[14] + ((size_t)ldg * 16 + c) * 64 + p), ci = *(const f32x4*)(a->in[15] + ((size_t)ldg * 16 + c) * 64 + p);
            v4u w; w.x = pk2(cr.x, -ci.x); w.y = pk2(cr.y, -ci.y); w.z = pk2(cr.z, -ci.z); w.w = pk2(cr.w, -ci.w); Cm[ks] = __builtin_bit_cast(bf16x8, w); }
        const int seqA = c >> 2, tokA = c & 3;
        const bf16* zA = Z + (size_t)(rowbase0 + seqA * L) * DIN + 16 * g + 8 * (r & 1);
        float* yp = YP + (size_t)d * M * 1024 + (size_t)(rowbase0 + seqA * L) * 1024 + 16 * g + 4 * r;
        f32x4 z4 = (f32x4){0.f, 0.f, 0.f, 0.f}; asm volatile("" : "+v"(z4));
        const bf16x8 zero8 = (bf16x8){0, 0, 0, 0, 0, 0, 0, 0};
        constexpr int nblk = 16;
        bf16x8 Ab[4], An[4];
#pragma unroll
        for (int s4 = 0; s4 < 4; ++s4) { const int pos = P0 + 4 * s4 + tokA, tt = d ? L - 1 - pos : pos; Ab[s4] = zero8; if (r < 2) Ab[s4] = *(const bf16x8*)(zA + (size_t)tt * DIN); }
        const unsigned wbase = (unsigned)((4 * r) * SSM_ROWB + 4 * c), rbase = (unsigned)(c * SSM_ROWB + 16 * r);
        for (int blk = 0; blk < nblk; ++blk) {
#pragma unroll
            for (int s4 = 0; s4 < 4; ++s4) { An[s4] = Ab[s4];
                if (blk + 1 < nblk && r < 2) { const int pos = P0 + 16 * (blk + 1) + 4 * s4 + tokA, tt = d ? L - 1 - pos : pos; An[s4] = *(const bf16x8*)(zA + (size_t)tt * DIN); } }
#pragma unroll
            for (int s4 = 0; s4 < 4; ++s4) {
                f32x4 D[8];
#pragma unroll
                for (int j = 0; j < 8; ++j) D[j] = __builtin_amdgcn_mfma_f32_16x16x32_bf16(Ab[s4], Bop[j], z4, 0, 0, 0);
                if (local) {
#pragma unroll
                    for (int i = 0; i < 4; ++i)
#pragma unroll
                        for (int t = 0; t < 4; ++t) {
                            const float nr = fmaf(ar[t], sr[t], fmaf(-ai[t], si[t], D[2 * t][i])), ni = fmaf(ar[t], si[t], fmaf(ai[t], sr[t], D[2 * t + 1][i]));
                            sr[t] = nr; si[t] = ni; }
                } else {
#pragma unroll
                for (int i = 0; i < 4; ++i) {
#pragma unroll
                    for (int t = 0; t < 4; ++t) {
                        const float nr = fmaf(ar[t], sr[t], fmaf(-ai[t], si[t], D[2 * t][i])), ni = fmaf(ar[t], si[t], fmaf(ai[t], sr[t], D[2 * t + 1][i]));
                        sr[t] = nr; si[t] = ni;
                        *(LAS unsigned*)(scr + wbase + i * SSM_ROWB + 64 * t) = pk2(nr, ni);
                    }
                }
                LDS_WAIT(); __builtin_amdgcn_wave_barrier(); asm volatile("" ::: "memory");
                f32x4 y, yb;
                { const bf16x8 f0 = *(const LAS bf16x8*)(scr + rbase), f1 = *(const LAS bf16x8*)(scr + rbase + 64), f2 = *(const LAS bf16x8*)(scr + rbase + 128), f3 = *(const LAS bf16x8*)(scr + rbase + 192);
                  y = __builtin_amdgcn_mfma_f32_16x16x32_bf16(Cm[0], f0, z4, 0, 0, 0); yb = __builtin_amdgcn_mfma_f32_16x16x32_bf16(Cm[1], f1, z4, 0, 0, 0);
                  y = __builtin_amdgcn_mfma_f32_16x16x32_bf16(Cm[2], f2, y, 0, 0, 0); yb = __builtin_amdgcn_mfma_f32_16x16x32_bf16(Cm[3], f3, yb, 0, 0, 0); y = y + yb; }
                { const int pos = P0 + 16 * blk + 4 * s4 + tokA, tt = d ? L - 1 - pos : pos; *(f32x4*)(yp + (size_t)tt * 1024) = y; }
                LDS_WAIT(); __builtin_amdgcn_wave_barrier(); asm volatile("" ::: "memory");
                }
            }
#pragma unroll
            for (int s4 = 0; s4 < 4; ++s4) Ab[s4] = An[s4];
        }
        if (!lat) { float* so = a->out + OUT_STATE + (size_t)(((b * 2 + l) * 2 + d) * 2) * 4096 + g * 64;
#pragma unroll
            for (int t = 0; t < 4; ++t) { so[c + 16 * t] = sr[t]; so[4096 + c + 16 * t] = si[t]; } }
        else if (pass == 0) { float* eo = EB + ((size_t)((b * 3 + k) * 2 + d) * 64 + g) * 128;
#pragma unroll
            for (int t = 0; t < 4; ++t) { eo[c + 16 * t] = sr[t]; eo[64 + c + 16 * t] = si[t]; } }
    }
    __builtin_amdgcn_s_setprio(0);
}

constexpr int NPH = 23;
__global__ void __launch_bounds__(NWAVES * 64, 2) fwd_megakernel(Args args_unused) {
    extern __shared__ __attribute__((aligned(16))) unsigned char lds[];
    for (int u = threadIdx.x; u < (LDS_BYTES - LDSCTL_OFF) / 4; u += NWAVES * 64) ((LAS unsigned*)((LAS unsigned char*)lds + LDSCTL_OFF))[u] = 0u;
    __syncthreads();
    int lo, hi;
    { KArgs a0 = get_args(); lo = a0->ph_lo; hi = a0->ph_hi;
      if (lo < 0) cooperative_groups::this_grid().sync();
      if (hi - lo > 1) (void)xcd_barrier_post((unsigned*)(a0->ws + WS_CTL), (volatile LAS unsigned*)((LAS unsigned char*)lds + MISC_OFF) + 8); }
#pragma unroll 1
    for (int ph = lo; ph < hi; ++ph) {
        KArgs a = get_args();
        Frame F;
        { int t = threadIdx.x; asm volatile("" : "+v"(t)); int gsz = gridDim.x; asm volatile("" : "+s"(gsz)); int bx = blockIdx.x; asm volatile("" : "+s"(bx));
          F.lds = (LAS unsigned char*)lds; F.MISC = (volatile LAS unsigned*)(F.lds + MISC_OFF);
          F.tid = t; F.lane = t & 63; F.wave = __builtin_amdgcn_readfirstlane(t >> 6); F.G = gsz; F.bx = bx; }
        unsigned char* ws = a->ws;
        const int l = ph >= 12 ? 1 : 0, kk = ph - 2 - 10 * l, k = kk <= 2 ? kk : kk - 1;
        float* X = (float*)(ws + WS_X); bf16* H = (bf16*)(ws + WS_H); bf16* CAT = (bf16*)(ws + WS_CAT); bf16* Yb = (bf16*)(ws + WS_Y);
        const float* modl = (const float*)(ws + WS_MOD) + (size_t)l * 9 * NMODC;
        if (ph == 0) p0_prologue(F, a);
        else if (ph == 1) continue;
        else if (ph == 22) final_norm_phase(F, X, a->in[25], a->out, F.G == 256 ? (const float*)(ws + WS_P) : nullptr);
        else if (k == 0 || k == 6) {
            const bool inp = (k == 0 && l == 0);
            const float* xlo = inp ? a->in[0] : X; const float* xhi = inp ? a->in[1] - (size_t)MCTX * D : X;
            norm_mod_phase(F, xlo, xhi, a->in[k == 0 ? 7 : 21] + (size_t)l * D, modl, k == 0 ? 0 : 3, k == 0 ? 1 : 4, H, (k == 0 && l == 1 && F.G == 256) ? (const float*)(ws + WS_P) : nullptr, X);
        }
        else if (k == 1) { pg8::Gemm g{H, (const bf16*)(ws + WS_WIN) + (size_t)l * 4096 * 2048, M, DIN, D, D}; pg8::StaticOrder S; S.init(M, DIN, F.G, F.bx);
            pg8::EpiStoreBf16 E{(bf16*)(ws + WS_Z), DIN}; pg8::gemm_phase<pg8::EpiStoreBf16, pg8::StaticOrder, true, true>(F.lds, g, S, E, F.tid); }
        else if (kk == 2 || kk == 3) { ssm_phase(F, a, l, kk - 2); ssm_side_work(F, a, l, kk - 2); }
        else if (k == 3) combine_phase(F, a, l);
        else if (k == 4) { pg8::Gemm g{Yb, (const bf16*)(ws + WS_WGLU) + (size_t)l * 1024 * 1024, M, DSSM, DSSM, DSSM}; pg8::StaticOrder S; S.init(M, DSSM, F.G, F.bx);
            pg8::EpiGLU E{Yb, DSSM, CAT, D}; pg8::gemm_phase<pg8::EpiGLU, pg8::StaticOrder, true, true>(F.lds, g, S, E, F.tid);
            if (l == 0) {
                const bool idle = F.G > 192; if (!idle || F.bx >= 192) { const int iw = (idle ? F.bx - 192 : F.bx) * NWAVES + F.wave, NIW = (idle ? F.G - 192 : F.G) * NWAVES;
                    LAS float* tscr = (LAS float*)(F.lds + F.wave * 16384);
                    for (int it = iw; it < 4000; it += NIW) p0_item(a, tscr, IT_EARLY + it, F.lane); } } }
        else if (k == 7) { pg8::Gemm g{H, (const bf16*)(ws + WS_WGU) + (size_t)l * 11264 * 2048, M, 2 * DFF, D, D}; pg8::StaticOrder S; S.init(M, 2 * DFF, F.G, F.bx);
            pg8::EpiSwiGLU E{(bf16*)(ws + WS_ACT), DFF}; pg8::gemm_phase<pg8::EpiSwiGLU, pg8::StaticOrder, true, true>(F.lds, g, S, E, F.tid); }
        else if (k == 5 || F.G != 256) {
            const bool op = (k == 5), inp = (op && l == 0);
            pg8::Gemm g{op ? CAT : (const bf16*)(ws + WS_ACT), op ? (const bf16*)(ws + WS_WOUT) + (size_t)l * 2048 * 2048 : (const bf16*)(ws + WS_WDN) + (size_t)l * 2048 * 5632, M, D, op ? D : DFF, op ? D : DFF};
            pg8::StaticOrder S; S.init(M, D, F.G, F.bx);
            pg8::EpiResid E{inp ? a->in[0] : X, inp ? a->in[1] - (size_t)MCTX * D : X, modl + (op ? 2 : 5) * D, X, nullptr, 0, 0};
            pg8::gemm_phase<pg8::EpiResid, pg8::StaticOrder, true, true>(F.lds, g, S, E, F.tid);
            if (op && l == 0) {
                const int nbusy = 384 - F.G;
                const bool tail = nbusy > 0 && nbusy < F.G;
                if (!tail || F.bx >= nbusy) { const int iw = (tail ? F.bx - nbusy : F.bx) * NWAVES + F.wave, NIW = (tail ? F.G - nbusy : F.G) * NWAVES;
                    LAS float* tscr = (LAS float*)(F.lds + F.wave * 16384);
                    for (int it = iw; it < IT_LAYER; it += NIW) p0_item(a, tscr, IT_LAYER + it, F.lane); } } }
        else {
            pg8::Gemm g{(const bf16*)(ws + WS_ACT), (const bf16*)(ws + WS_WDN) + (size_t)l * 2048 * 5632, M, D, DFF / 2, DFF};
            pg8::SplitOrder S{F.bx};
            pg8::EpiResid E{X, X, modl + 5 * D, X, (float*)(ws + WS_P), 8192, 4096};
            pg8::gemm_phase<pg8::EpiResid, pg8::SplitOrder, true, true>(F.lds, g, S, E, F.tid); }
        if (ph + 1 < hi) { XcdBarrier bar; bar.bar = (unsigned*)(ws + WS_CTL); bar.x = xb_xcc_id(); bar.st = F.MISC + 8; xcd_barrier(bar); }
    }
}

extern "C" void kernel_launch(void* const* d_in, const int* in_sizes, int n_in, void* d_out, int out_size, void* d_ws, size_t ws_size, hipStream_t stream) {
    static int grid = 0;
    if (grid == 0) {
        if (n_in != 26 || ws_size < WS_END) { fprintf(stderr, "kernel_launch: unexpected n_in %d / ws %zu\n", n_in, ws_size); grid = -1; return; }
        int dev = 0, cus = 0, per_cu = 0;
        if (hipGetDevice(&dev) != hipSuccess || hipDeviceGetAttribute(&cus, hipDeviceAttributeMultiprocessorCount, dev) != hipSuccess) { grid = -1; return; }
        if (hipFuncSetAttribute((const void*)fwd_megakernel, hipFuncAttributeMaxDynamicSharedMemorySize, LDS_BYTES) != hipSuccess) { fprintf(stderr, "kernel_launch: hipFuncSetAttribute failed\n"); grid = -1; return; }
        if (hipOccupancyMaxActiveBlocksPerMultiprocessor(&per_cu, (const void*)fwd_megakernel, NWAVES * 64, LDS_BYTES) != hipSuccess || per_cu < 1) { fprintf(stderr, "kernel_launch: occupancy query says %d\n", per_cu); per_cu = 1; }
        (void)hipGetLastError();
        grid = cus;
    }
    if (grid < 0) return;
    Args a{};
    for (int i = 0; i < 26; ++i) a.in[i] = (const float*)d_in[i];
    a.out = (float*)d_out; a.ws = (unsigned char*)d_ws;
#if MK_ONE_LAUNCH
    (void)hipMemsetAsync((char*)d_ws + WS_CTL, 0, CTL_ZERO_BYTES, stream);
    a.ph_lo = 0; a.ph_hi = NPH;
    void* kargs[] = {&a};
    hipError_t e = hipLaunchCooperativeKernel((const void*)fwd_megakernel, dim3(grid), dim3(NWAVES * 64), kargs, LDS_BYTES, stream);
    if (e != hipSuccess) fprintf(stderr, "cooperative launch failed: %s (grid %d)\n", hipGetErrorString(e), grid);
#else
    for (int p = 0; p < NPH; ++p) { a.ph_lo = p; a.ph_hi = p + 1; hipLaunchKernelGGL(fwd_megakernel, dim3(grid), dim3(NWAVES * 64), LDS_BYTES, stream, a); }
#endif
}
```
